# Optimizing an MI355X kernel written in HIP

```python
import math
import jax
import jax.numpy as jnp
from jax import lax
import numpy as np

D_MODEL = 1024
BATCH = 8
SEQ = 4096
DEPTH = 1

HEAD_DIM = 64
A_Q_HEADS = 8
A_KV_HEADS = 2
A_WINDOW = 128
B_GROUPS = ((128, 1), (512, 4), (2048, 16))
B_HEADS_PER_GROUP = 8
A_WIDTH = A_Q_HEADS * HEAD_DIM
B_WIDTH = B_HEADS_PER_GROUP * HEAD_DIM
N_BRANCHES = 2
N_BUCKETS = 32
MAX_DISTANCE = 1024
REL_HEADS = A_Q_HEADS + len(B_GROUPS) * B_HEADS_PER_GROUP
PROJ_SIZES = (A_WIDTH, A_KV_HEADS * HEAD_DIM, A_KV_HEADS * HEAD_DIM,
              len(B_GROUPS) * B_WIDTH, len(B_GROUPS) * B_WIDTH, len(B_GROUPS) * B_WIDTH,
              A_WIDTH, B_WIDTH, N_BRANCHES * D_MODEL)
IN_WIDTH = sum(PROJ_SIZES)
EPS = 1e-6
NEG_INF = -1e30

kernel_name = "hybrid_gated_window_dilated_attention_block"


def rms_norm(x, gain):
    xf = x.astype(jnp.float32)
    y = xf * lax.rsqrt(jnp.mean(xf * xf, axis=-1, keepdims=True) + EPS)
    return (y * gain.astype(jnp.float32)).astype(x.dtype)


def t5_bucket(rel):
    half = N_BUCKETS // 2
    max_exact = half // 2
    ret = (rel > 0).astype(jnp.int32) * half
    n = jnp.abs(rel)
    nf = jnp.maximum(n, max_exact).astype(jnp.float32)
    large = max_exact + (jnp.log(nf / max_exact) / math.log(MAX_DISTANCE / max_exact)
                         * (half - max_exact)).astype(jnp.int32)
    large = jnp.minimum(large, half - 1)
    return ret + jnp.where(n < max_exact, n, large)


def banded_attention(q, k, v, half_window, stride, bias_table, sink):
    bsz, L, H, dh = q.shape
    KV = k.shape[2]
    G = H // KV
    blk = half_window
    nb = -(-L // blk)
    Lp = nb * blk
    pad = Lp - L
    qb = jnp.pad(q, ((0, 0), (0, pad), (0, 0), (0, 0))).reshape(bsz, nb, blk, KV, G, dh)

    def windows(t):
        tp = jnp.pad(t, ((0, 0), (blk, blk + pad), (0, 0), (0, 0))).reshape(bsz, nb + 2, blk, KV, dh)
        return jnp.concatenate([tp[:, :-2], tp[:, 1:-1], tp[:, 2:]], axis=2)

    kw = windows(k)
    vw = windows(v)
    scores = jnp.einsum('bnqkgd,bnmkd->bkgnqm', qb, kw).astype(jnp.float32)

    qi = jnp.arange(blk)
    mi = jnp.arange(3 * blk)
    rel = mi[None, :] - blk - qi[:, None]
    bias = bias_table[t5_bucket(rel * stride)]
    bias = bias.transpose(2, 0, 1).reshape(KV, G, 1, blk, 3 * blk).astype(jnp.float32)
    blocks = jnp.arange(nb)[:, None, None] * blk
    qpos = blocks + qi[None, :, None]
    kpos = blocks - blk + mi[None, None, :]
    valid = (kpos >= 0) & (kpos < L) & (jnp.abs(kpos - qpos) <= half_window)

    logits = jnp.where(valid, scores + bias, NEG_INF)
    lse = jax.nn.logsumexp(logits, axis=-1)
    if sink is not None:
        lse = jnp.logaddexp(lse, sink.astype(jnp.float32).reshape(KV, G, 1, 1))
    probs = jnp.exp(logits - lse[..., None])
    out = jnp.einsum('bkgnqm,bnmkd->bnqkgd', probs.astype(v.dtype), vw)
    out = out.reshape(bsz, Lp, H, dh)[:, :L]
    lse = lse.transpose(0, 3, 4, 1, 2).reshape(bsz, Lp, H)[:, :L]
    return out, lse


def dilated_group(q, k, v, window, dilation, bias_table):
    bsz, S, H, dh = q.shape
    L = S // dilation

    def to_sub(t):
        return t.reshape(bsz, L, dilation, H, dh).transpose(0, 2, 1, 3, 4).reshape(bsz * dilation, L, H, dh)

    out, lse = banded_attention(to_sub(q), to_sub(k), to_sub(v), window // (2 * dilation),
                                dilation, bias_table, None)
    out = out.reshape(bsz, dilation, L, H, dh).transpose(0, 2, 1, 3, 4).reshape(bsz, S, H, dh)
    lse = lse.reshape(bsz, dilation, L, H).transpose(0, 2, 1, 3).reshape(bsz, S, H)
    return out, lse


def head_rms_norm(t, gain):
    return rms_norm(t, gain)


def setup_inputs(seed: int = 0) -> dict:
    key = jax.random.key(seed)
    ks = jax.random.split(key, 16)
    f32 = jnp.float32
    x = jax.random.normal(ks[0], (BATCH, SEQ, D_MODEL), f32)
    norm_gain = 1.0 + 0.02 * jax.random.normal(ks[1], (DEPTH, D_MODEL), f32)
    w_in = jax.random.normal(ks[2], (DEPTH, D_MODEL, IN_WIDTH), f32) * D_MODEL ** -0.5
    q_norm_a = 1.0 + 0.02 * jax.random.normal(ks[3], (DEPTH, HEAD_DIM), f32)
    k_norm_a = 1.0 + 0.02 * jax.random.normal(ks[4], (DEPTH, HEAD_DIM), f32)
    q_norm_b = 1.0 + 0.02 * jax.random.normal(ks[5], (DEPTH, HEAD_DIM), f32)
    k_norm_b = 1.0 + 0.02 * jax.random.normal(ks[6], (DEPTH, HEAD_DIM), f32)
    sink_a = 0.5 * jax.random.normal(ks[7], (DEPTH, A_Q_HEADS), f32)
    rel_bias = 0.5 * jax.random.normal(ks[8], (N_BUCKETS, REL_HEADS), f32)
    w_branch_a = jax.random.normal(ks[9], (DEPTH, A_WIDTH, D_MODEL), f32) * A_WIDTH ** -0.5
    w_branch_b = jax.random.normal(ks[10], (DEPTH, B_WIDTH, D_MODEL), f32) * B_WIDTH ** -0.5
    b_merge = 0.1 * jax.random.normal(ks[11], (DEPTH, N_BRANCHES, D_MODEL), f32)
    w_out = jax.random.normal(ks[12], (DEPTH, D_MODEL, D_MODEL), f32) * D_MODEL ** -0.5
    return {"x": x, "norm_gain": norm_gain, "w_in": w_in, "q_norm_a": q_norm_a,
            "k_norm_a": k_norm_a, "q_norm_b": q_norm_b, "k_norm_b": k_norm_b,
            "sink_a": sink_a, "rel_bias": rel_bias, "w_branch_a": w_branch_a,
            "w_branch_b": w_branch_b, "b_merge": b_merge, "w_out": w_out}


def reference(x, norm_gain, w_in, q_norm_a, k_norm_a, q_norm_b, k_norm_b, sink_a,
              rel_bias, w_branch_a, w_branch_b, b_merge, w_out):
    bsz, S, D = x.shape
    n_groups = len(B_GROUPS)
    scale = HEAD_DIM ** -0.5
    split_idx = [int(i) for i in np.cumsum(PROJ_SIZES)[:-1]]
    for layer in range(DEPTH):
        h = rms_norm(x, norm_gain[layer])
        proj = h @ w_in[layer]
        qa, ka, va, qb, kb, vb, ga, gb, mg = jnp.split(proj, split_idx, axis=-1)

        qa = head_rms_norm(qa.reshape(bsz, S, A_Q_HEADS, HEAD_DIM), q_norm_a[layer]) * scale
        ka = head_rms_norm(ka.reshape(bsz, S, A_KV_HEADS, HEAD_DIM), k_norm_a[layer])
        va = va.reshape(bsz, S, A_KV_HEADS, HEAD_DIM)
        ya, _ = banded_attention(qa, ka, va, A_WINDOW, 1, rel_bias[:, :A_Q_HEADS], sink_a[layer])
        ya = ya.reshape(bsz, S, A_WIDTH) * jax.nn.silu(ga)

        qb = head_rms_norm(qb.reshape(bsz, S, n_groups, B_HEADS_PER_GROUP, HEAD_DIM), q_norm_b[layer]) * scale
        kb = head_rms_norm(kb.reshape(bsz, S, n_groups, B_HEADS_PER_GROUP, HEAD_DIM), k_norm_b[layer])
        vb = vb.reshape(bsz, S, n_groups, B_HEADS_PER_GROUP, HEAD_DIM)
        outs = []
        lses = []
        for g, (window, dilation) in enumerate(B_GROUPS):
            c0 = A_Q_HEADS + g * B_HEADS_PER_GROUP
            o, l = dilated_group(qb[:, :, g], kb[:, :, g], vb[:, :, g], window, dilation,
                                 rel_bias[:, c0:c0 + B_HEADS_PER_GROUP])
            outs.append(o)
            lses.append(l)
        alpha = jax.nn.softmax(jnp.stack(lses, axis=0), axis=0)
        yb = jnp.sum(alpha[..., None].astype(x.dtype) * jnp.stack(outs, axis=0), axis=0)
        yb = yb.reshape(bsz, S, B_WIDTH) * jax.nn.silu(gb)

        br_a = ya @ w_branch_a[layer]
        br_b = yb @ w_branch_b[layer]
        gates = jax.nn.sigmoid(mg.reshape(bsz, S, N_BRANCHES, D).astype(jnp.float32)
                               + b_merge[layer].astype(jnp.float32)).astype(x.dtype)
        merged = gates[:, :, 0] * br_a + gates[:, :, 1] * br_b
        x = x + merged @ w_out[layer]
    return x
```

```cpp
#include <hip/hip_runtime.h>
#include <cstdint>
#include <cstdio>

typedef unsigned short bf16_t;
constexpr int BATCH = 8, SEQ = 4096, DM = 1024, MTOK = BATCH * SEQ;
constexpr int NIN = 8448;
constexpr int C_QA = 0, C_KA = 512, C_VA = 640, C_QB = 768, C_KB = 2304, C_VB = 3840, C_GA = 5376, C_GB = 5888, C_MG = 6400;
constexpr int QKV_LD = 5376;
constexpr float LOG2E = 1.4426950408889634f;
constexpr float QSCALE = 0.125f * LOG2E;
constexpr float EPS = 1e-6f;

constexpr size_t MiB = (size_t)1 << 20;
constexpr size_t WS_CTL = 0, WS_WIN = 1 * MiB, WS_WAB = 18 * MiB, WS_WOUT = 20 * MiB, WS_LSE = 22 * MiB, WS_XN = 26 * MiB, WS_GAB = 90 * MiB, WS_QKV = 154 * MiB, WS_END = 490 * MiB;

__device__ __forceinline__ unsigned f2bf(float f) { unsigned u = __builtin_bit_cast(unsigned, f); return (u + 0x7fffu + ((u >> 16) & 1u)) >> 16; }
__device__ __forceinline__ float bf2f(unsigned b) { return __builtin_bit_cast(float, b << 16); }
__device__ __forceinline__ unsigned pk2(float lo, float hi) { return f2bf(lo) | (f2bf(hi) << 16); }

__global__ __launch_bounds__(256) void p0_naive(const float* __restrict__ x, const float* __restrict__ gain, bf16_t* __restrict__ XN) {
    const int lane = threadIdx.x & 63, wave = threadIdx.x >> 6;
    const int row = blockIdx.x * 4 + wave;
    const float4* xr = (const float4*)(x + (size_t)row * DM) + lane;
    float4 v[4]; float s = 0.f;
#pragma unroll
    for (int j = 0; j < 4; ++j) { v[j] = xr[64 * j]; s += v[j].x * v[j].x + v[j].y * v[j].y + v[j].z * v[j].z + v[j].w * v[j].w; }
#pragma unroll
    for (int o = 1; o < 64; o <<= 1) s += __shfl_xor(s, o);
    const float rstd = rsqrtf(s * (1.f / DM) + EPS);
    uint2* o8 = (uint2*)(XN + (size_t)row * DM) + lane;
#pragma unroll
    for (int j = 0; j < 4; ++j) { const float4 g = ((const float4*)gain)[lane + 64 * j];
        uint2 w; w.x = pk2(v[j].x * rstd * g.x, v[j].y * rstd * g.y); w.y = pk2(v[j].z * rstd * g.z, v[j].w * rstd * g.w); o8[64 * j] = w; }
}

__device__ __forceinline__ void tile_gemm(float (&acc)[4][4], const bf16_t* A, int lda, const float* B, int ldb, int K, float* As, float* Bs) {
    const int tid = threadIdx.x, ty = tid >> 4, tx = tid & 15;
    for (int k0 = 0; k0 < K; k0 += 16) {
        { const int r = tid >> 2, kk = (tid & 3) * 4; const uint2 v = *(const uint2*)(A + (size_t)r * lda + k0 + kk);
          As[(kk + 0) * 68 + r] = bf2f(v.x & 0xffffu); As[(kk + 1) * 68 + r] = bf2f(v.x >> 16); As[(kk + 2) * 68 + r] = bf2f(v.y & 0xffffu); As[(kk + 3) * 68 + r] = bf2f(v.y >> 16); }
        { const int kk = tid >> 4, c = (tid & 15) * 4; *(float4*)&Bs[kk * 64 + c] = *(const float4*)(B + (size_t)(k0 + kk) * ldb + c); }
        __syncthreads();
#pragma unroll
        for (int kk = 0; kk < 16; ++kk) {
            const float4 a = *(const float4*)&As[kk * 68 + ty * 4]; const float4 b = *(const float4*)&Bs[kk * 64 + tx * 4];
            const float av[4] = {a.x, a.y, a.z, a.w}, bv[4] = {b.x, b.y, b.z, b.w};
#pragma unroll
            for (int i = 0; i < 4; ++i)
#pragma unroll
                for (int j = 0; j < 4; ++j) acc[i][j] += av[i] * bv[j];
        }
        __syncthreads();
    }
}

__global__ __launch_bounds__(256) void p1_naive(const bf16_t* __restrict__ XN, const float* __restrict__ Win, const float* qna, const float* kna, const float* qnb, const float* knb,
                                                const float* bmerge, bf16_t* QKV, bf16_t* GAB, bf16_t* Rb, bf16_t* G1b) {
    __shared__ float As[16 * 68], Bs[16 * 64];
    const int tn = blockIdx.x, row0 = blockIdx.y * 64, tid = threadIdx.x, ty = tid >> 4, tx = tid & 15;
    const bf16_t* A = XN + (size_t)row0 * DM;
    if (tn < 100) {
        const int col0 = tn * 64;
        float acc[4][4] = {};
        tile_gemm(acc, A, DM, Win + col0, NIN, DM, As, Bs);
        const float* gain = nullptr; float sc = 1.f;
        if (col0 < C_KA) { gain = qna; sc = QSCALE; } else if (col0 < C_VA) { gain = kna; } else if (col0 < C_QB) { } else if (col0 < C_KB) { gain = qnb; sc = QSCALE; } else if (col0 < C_VB) { gain = knb; }
#pragma unroll
        for (int i = 0; i < 4; ++i) {
            const int row = row0 + ty * 4 + i;
            float v[4] = {acc[i][0], acc[i][1], acc[i][2], acc[i][3]};
            if (gain) {
                float ss = v[0] * v[0] + v[1] * v[1] + v[2] * v[2] + v[3] * v[3];
                ss += __shfl_xor(ss, 1); ss += __shfl_xor(ss, 2); ss += __shfl_xor(ss, 4); ss += __shfl_xor(ss, 8);
                const float rstd = rsqrtf(ss * (1.f / 64.f) + EPS);
#pragma unroll
                for (int j = 0; j < 4; ++j) v[j] = v[j] * rstd * gain[tx * 4 + j] * sc;
            }
            uint2 w; w.x = pk2(v[0], v[1]); w.y = pk2(v[2], v[3]);
            if (col0 < C_GA) *(uint2*)(QKV + (size_t)row * QKV_LD + col0 + tx * 4) = w;
            else *(uint2*)(GAB + (size_t)row * 1024 + (col0 - C_GA) + tx * 4) = w;
        }
    } else {
        const int c0 = (tn - 100) * 64;
        float a0[4][4] = {}, a1[4][4] = {};
        tile_gemm(a0, A, DM, Win + C_MG + c0, NIN, DM, As, Bs);
        tile_gemm(a1, A, DM, Win + C_MG + 1024 + c0, NIN, DM, As, Bs);
#pragma unroll
        for (int i = 0; i < 4; ++i) {
            const int row = row0 + ty * 4 + i; float r[4], g[4];
#pragma unroll
            for (int j = 0; j < 4; ++j) { const int c = c0 + tx * 4 + j; const float g0 = 1.f / (1.f + __expf(-(a0[i][j] + bmerge[c]))), g1 = 1.f / (1.f + __expf(-(a1[i][j] + bmerge[1024 + c]))); r[j] = g0 / g1; g[j] = g1; }
            uint2 w; w.x = pk2(r[0], r[1]); w.y = pk2(r[2], r[3]); *(uint2*)(Rb + (size_t)row * 1024 + c0 + tx * 4) = w;
            w.x = pk2(g[0], g[1]); w.y = pk2(g[2], g[3]); *(uint2*)(G1b + (size_t)row * 1024 + c0 + tx * 4) = w;
        }
    }
}

__device__ __forceinline__ int t5_bucket(int rel) {
    const int n = rel < 0 ? -rel : rel; const int ret = rel > 0 ? 16 : 0;
    if (n < 8) return ret + n;
    int large = 8 + (int)(logf((float)n / 8.f) / 4.852030263919617f * 8.f);
    if (large > 15) large = 15;
    return ret + large;
}
template <int PROB>
__global__ __launch_bounds__(256) void attn_naive(bf16_t* QKV, const bf16_t* __restrict__ GAB, const float* __restrict__ rel_bias, const float* __restrict__ sink, float* LSE) {
    constexpr int dil = PROB == 0 ? 1 : (PROB == 1 ? 1 : (PROB == 2 ? 4 : 16));
    constexpr int HW = PROB == 0 ? 128 : 64;
    __shared__ float sb[2 * HW + 1];
    const int h = blockIdx.y, t = blockIdx.x * 256 + threadIdx.x, b = t / SEQ, s = t % SEQ;
    const int qcol = PROB == 0 ? C_QA + h * 64 : C_QB + (PROB - 1) * 512 + h * 64;
    const int kcol = PROB == 0 ? C_KA + (h >> 2) * 64 : C_KB + (PROB - 1) * 512 + h * 64;
    const int vcol = PROB == 0 ? C_VA + (h >> 2) * 64 : C_VB + (PROB - 1) * 512 + h * 64;
    const int bh = PROB == 0 ? h : 8 + (PROB - 1) * 8 + h;
    for (int j = threadIdx.x; j < 2 * HW + 1; j += 256) sb[j] = rel_bias[t5_bucket((j - HW) * dil) * 32 + bh] * LOG2E;
    __syncthreads();
    float q[64], o[64];
    { const uint4* qp = (const uint4*)(QKV + (size_t)t * QKV_LD + qcol);
#pragma unroll
      for (int c = 0; c < 8; ++c) { const uint4 v = qp[c]; q[8 * c + 0] = bf2f(v.x & 0xffffu); q[8 * c + 1] = bf2f(v.x >> 16); q[8 * c + 2] = bf2f(v.y & 0xffffu); q[8 * c + 3] = bf2f(v.y >> 16);
          q[8 * c + 4] = bf2f(v.z & 0xffffu); q[8 * c + 5] = bf2f(v.z >> 16); q[8 * c + 6] = bf2f(v.w & 0xffffu); q[8 * c + 7] = bf2f(v.w >> 16); } }
#pragma unroll
    for (int i = 0; i < 64; ++i) o[i] = 0.f;
    float m = -1e30f, l = 0.f;
    for (int j = -HW; j <= HW; ++j) {
        const int s2 = s + j * dil; if (s2 < 0 || s2 >= SEQ) continue;
        const size_t rowoff = (size_t)(b * SEQ + s2) * QKV_LD;
        const uint4* kp = (const uint4*)(QKV + rowoff + kcol);
        float dot = 0.f;
#pragma unroll
        for (int c = 0; c < 8; ++c) { const uint4 v = kp[c];
            dot += q[8 * c + 0] * bf2f(v.x & 0xffffu) + q[8 * c + 1] * bf2f(v.x >> 16) + q[8 * c + 2] * bf2f(v.y & 0xffffu) + q[8 * c + 3] * bf2f(v.y >> 16)
                 + q[8 * c + 4] * bf2f(v.z & 0xffffu) + q[8 * c + 5] * bf2f(v.z >> 16) + q[8 * c + 6] * bf2f(v.w & 0xffffu) + q[8 * c + 7] * bf2f(v.w >> 16); }
        const float sc = dot + sb[j + HW];
        const float mn = fmaxf(m, sc), a = exp2f(m - mn), p = exp2f(sc - mn);
        l = l * a + p; m = mn;
        const uint4* vp = (const uint4*)(QKV + rowoff + vcol);
#pragma unroll
        for (int c = 0; c < 8; ++c) { const uint4 v = vp[c];
            o[8 * c + 0] = o[8 * c + 0] * a + p * bf2f(v.x & 0xffffu); o[8 * c + 1] = o[8 * c + 1] * a + p * bf2f(v.x >> 16); o[8 * c + 2] = o[8 * c + 2] * a + p * bf2f(v.y & 0xffffu); o[8 * c + 3] = o[8 * c + 3] * a + p * bf2f(v.y >> 16);
            o[8 * c + 4] = o[8 * c + 4] * a + p * bf2f(v.z & 0xffffu); o[8 * c + 5] = o[8 * c + 5] * a + p * bf2f(v.z >> 16); o[8 * c + 6] = o[8 * c + 6] * a + p * bf2f(v.w & 0xffffu); o[8 * c + 7] = o[8 * c + 7] * a + p * bf2f(v.w >> 16); }
    }
    float inv;
    if (PROB == 0) { const float sk = sink[h] * LOG2E; const float mn = fmaxf(m, sk); const float a = exp2f(m - mn); const float lt = l * a + exp2f(sk - mn); inv = a / lt; }
    else { inv = 1.f / l; LSE[(size_t)(PROB - 1) * MTOK * 8 + (size_t)t * 8 + h] = m + log2f(l); }
    uint4* op = (uint4*)(QKV + (size_t)t * QKV_LD + qcol);
#pragma unroll
    for (int c = 0; c < 8; ++c) {
        float r[8];
#pragma unroll
        for (int e = 0; e < 8; ++e) r[e] = o[8 * c + e] * inv;
        if (PROB == 0) { const uint4 g = ((const uint4*)(GAB + (size_t)t * 1024 + h * 64))[c]; const unsigned gw[4] = {g.x, g.y, g.z, g.w};
#pragma unroll
            for (int e = 0; e < 8; ++e) { const float gv = bf2f((e & 1) ? (gw[e >> 1] >> 16) : (gw[e >> 1] & 0xffffu)); r[e] *= gv / (1.f + __expf(-gv)); } }
        uint4 w; w.x = pk2(r[0], r[1]); w.y = pk2(r[2], r[3]); w.z = pk2(r[4], r[5]); w.w = pk2(r[6], r[7]); op[c] = w;
    }
}

__global__ __launch_bounds__(256) void p2c_combine(bf16_t* QKV, const bf16_t* __restrict__ GAB, const float* __restrict__ LSE) {
    const int lane = threadIdx.x & 63, wave = threadIdx.x >> 6;
    const int t = blockIdx.x * 4 + wave, h = lane >> 3;
    float ls[3], mx = -1e30f;
#pragma unroll
    for (int g = 0; g < 3; ++g) { ls[g] = LSE[(size_t)g * MTOK * 8 + (size_t)t * 8 + h]; mx = fmaxf(mx, ls[g]); }
    float al[3], sum = 0.f;
#pragma unroll
    for (int g = 0; g < 3; ++g) { al[g] = exp2f(ls[g] - mx); sum += al[g]; }
    const float inv = 1.f / sum;
    float r[8] = {0.f, 0.f, 0.f, 0.f, 0.f, 0.f, 0.f, 0.f};
#pragma unroll
    for (int g = 0; g < 3; ++g) { const uint4 v = *(const uint4*)(QKV + (size_t)t * QKV_LD + C_QB + g * 512 + lane * 8); const unsigned w[4] = {v.x, v.y, v.z, v.w}; const float a = al[g] * inv;
#pragma unroll
        for (int e = 0; e < 8; ++e) r[e] += a * bf2f((e & 1) ? (w[e >> 1] >> 16) : (w[e >> 1] & 0xffffu)); }
    { const uint4 g = *(const uint4*)(GAB + (size_t)t * 1024 + 512 + lane * 8); const unsigned gw[4] = {g.x, g.y, g.z, g.w};
#pragma unroll
      for (int e = 0; e < 8; ++e) { const float gv = bf2f((e & 1) ? (gw[e >> 1] >> 16) : (gw[e >> 1] & 0xffffu)); r[e] *= gv / (1.f + __expf(-gv)); } }
    uint4 w; w.x = pk2(r[0], r[1]); w.y = pk2(r[2], r[3]); w.z = pk2(r[4], r[5]); w.w = pk2(r[6], r[7]);
    *(uint4*)(QKV + (size_t)t * QKV_LD + 512 + lane * 8) = w;
}

__global__ __launch_bounds__(256) void p3_naive(const bf16_t* __restrict__ QKV, const float* __restrict__ Wa, const float* __restrict__ Wb, const bf16_t* __restrict__ Rb, const bf16_t* __restrict__ G1b, bf16_t* MER) {
    __shared__ float As[16 * 68], Bs[16 * 64];
    const int col0 = blockIdx.x * 64, row0 = blockIdx.y * 64, tid = threadIdx.x, ty = tid >> 4, tx = tid & 15;
    float aa[4][4] = {}, ab[4][4] = {};
    tile_gemm(aa, QKV + (size_t)row0 * QKV_LD, QKV_LD, Wa + col0, 1024, 512, As, Bs);
    tile_gemm(ab, QKV + (size_t)row0 * QKV_LD + 512, QKV_LD, Wb + col0, 1024, 512, As, Bs);
#pragma unroll
    for (int i = 0; i < 4; ++i) {
        const int row = row0 + ty * 4 + i; float v[4];
        const uint2 rr = *(const uint2*)(Rb + (size_t)row * 1024 + col0 + tx * 4), gg = *(const uint2*)(G1b + (size_t)row * 1024 + col0 + tx * 4);
        const float rv[4] = {bf2f(rr.x & 0xffffu), bf2f(rr.x >> 16), bf2f(rr.y & 0xffffu), bf2f(rr.y >> 16)}, gv[4] = {bf2f(gg.x & 0xffffu), bf2f(gg.x >> 16), bf2f(gg.y & 0xffffu), bf2f(gg.y >> 16)};
#pragma unroll
        for (int j = 0; j < 4; ++j) v[j] = gv[j] * (rv[j] * aa[i][j] + ab[i][j]);
        uint2 w; w.x = pk2(v[0], v[1]); w.y = pk2(v[2], v[3]); *(uint2*)(MER + (size_t)row * 1024 + col0 + tx * 4) = w;
    }
}
__global__ __launch_bounds__(256) void p4_naive(const bf16_t* __restrict__ MER, const float* __restrict__ Wout, const float* __restrict__ x, float* out) {
    __shared__ float As[16 * 68], Bs[16 * 64];
    const int col0 = blockIdx.x * 64, row0 = blockIdx.y * 64, tid = threadIdx.x, ty = tid >> 4, tx = tid & 15;
    float acc[4][4] = {};
    tile_gemm(acc, MER + (size_t)row0 * 1024, 1024, Wout + col0, 1024, 1024, As, Bs);
#pragma unroll
    for (int i = 0; i < 4; ++i) { const size_t off = (size_t)(row0 + ty * 4 + i) * 1024 + col0 + tx * 4; const float4 xv = *(const float4*)(x + off);
        *(float4*)(out + off) = make_float4(xv.x + acc[i][0], xv.y + acc[i][1], xv.z + acc[i][2], xv.w + acc[i][3]); }
}

extern "C" void kernel_launch(void* const* d_in, const int* in_sizes, int n_in, void* d_out, int out_size, void* d_ws, size_t ws_size, hipStream_t stream) {
    if (n_in != 13 || out_size != MTOK * DM || ws_size < WS_END) { fprintf(stderr, "kernel_launch: unexpected shapes (n_in %d out %d ws %zu)\n", n_in, out_size, ws_size); return; }
    const float* x = (const float*)d_in[0]; const float* gain = (const float*)d_in[1]; const float* Win = (const float*)d_in[2];
    const float *qna = (const float*)d_in[3], *kna = (const float*)d_in[4], *qnb = (const float*)d_in[5], *knb = (const float*)d_in[6], *sink = (const float*)d_in[7], *relb = (const float*)d_in[8];
    const float *Wa = (const float*)d_in[9], *Wb = (const float*)d_in[10], *bm = (const float*)d_in[11], *Wout = (const float*)d_in[12];
    unsigned char* ws = (unsigned char*)d_ws;
    bf16_t* XN = (bf16_t*)(ws + WS_XN); bf16_t* MER = XN; bf16_t* GAB = (bf16_t*)(ws + WS_GAB); bf16_t* QKV = (bf16_t*)(ws + WS_QKV); float* LSE = (float*)(ws + WS_LSE);
    bf16_t* Rb = (bf16_t*)d_out; bf16_t* G1b = Rb + (size_t)MTOK * 1024;
    p0_naive<<<MTOK / 4, 256, 0, stream>>>(x, gain, XN);
    p1_naive<<<dim3(116, MTOK / 64), 256, 0, stream>>>(XN, Win, qna, kna, qnb, knb, bm, QKV, GAB, Rb, G1b);
    attn_naive<0><<<dim3(MTOK / 256, 8), 256, 0, stream>>>(QKV, GAB, relb, sink, LSE);
    attn_naive<1><<<dim3(MTOK / 256, 8), 256, 0, stream>>>(QKV, GAB, relb, sink, LSE);
    attn_naive<2><<<dim3(MTOK / 256, 8), 256, 0, stream>>>(QKV, GAB, relb, sink, LSE);
    attn_naive<3><<<dim3(MTOK / 256, 8), 256, 0, stream>>>(QKV, GAB, relb, sink, LSE);
    p2c_combine<<<MTOK / 4, 256, 0, stream>>>(QKV, GAB, LSE);
    p3_naive<<<dim3(16, MTOK / 64), 256, 0, stream>>>(QKV, Wa, Wb, Rb, G1b, MER);
    p4_naive<<<dim3(16, MTOK / 64), 256, 0, stream>>>(MER, Wout, x, (float*)d_out);
}
```

```cpp
#define MEGA_MASK 0x3f
#define ONE_LAUNCH 1
#include <hip/hip_runtime.h>
#include <cstdint>
#include <cstdio>

typedef unsigned short bf16_t;
constexpr int BATCH = 8, SEQ = 4096, DM = 1024, MTOK = BATCH * SEQ;
constexpr int NIN = 8448;
constexpr int C_QA = 0, C_KA = 512, C_VA = 640, C_QB = 768, C_KB = 2304, C_VB = 3840, C_GA = 5376, C_GB = 5888, C_MG = 6400;
constexpr int QKV_LD = 5376;
constexpr float LOG2E = 1.4426950408889634f;
constexpr float QSCALE = 0.125f * LOG2E;
constexpr float EPS = 1e-6f;

constexpr size_t MiB = (size_t)1 << 20;
constexpr size_t WS_CTL = 0, WS_WIN = 1 * MiB, WS_WAB = 18 * MiB, WS_WOUT = 20 * MiB, WS_LSE = 22 * MiB, WS_XN = 26 * MiB, WS_GAB = 90 * MiB, WS_QKV = 154 * MiB, WS_END = 490 * MiB;

__device__ __forceinline__ unsigned f2bf(float f) { unsigned u = __builtin_bit_cast(unsigned, f); return (u + 0x7fffu + ((u >> 16) & 1u)) >> 16; }
__device__ __forceinline__ float bf2f(unsigned b) { return __builtin_bit_cast(float, b << 16); }
__device__ __forceinline__ unsigned pk2(float lo, float hi) { return f2bf(lo) | (f2bf(hi) << 16); }

__global__ __launch_bounds__(256) void p0_naive(const float* __restrict__ x, const float* __restrict__ gain, bf16_t* __restrict__ XN) {
    const int lane = threadIdx.x & 63, wave = threadIdx.x >> 6;
    const int row = blockIdx.x * 4 + wave;
    const float4* xr = (const float4*)(x + (size_t)row * DM) + lane;
    float4 v[4]; float s = 0.f;
#pragma unroll
    for (int j = 0; j < 4; ++j) { v[j] = xr[64 * j]; s += v[j].x * v[j].x + v[j].y * v[j].y + v[j].z * v[j].z + v[j].w * v[j].w; }
#pragma unroll
    for (int o = 1; o < 64; o <<= 1) s += __shfl_xor(s, o);
    const float rstd = rsqrtf(s * (1.f / DM) + EPS);
    uint2* o8 = (uint2*)(XN + (size_t)row * DM) + lane;
#pragma unroll
    for (int j = 0; j < 4; ++j) { const float4 g = ((const float4*)gain)[lane + 64 * j];
        uint2 w; w.x = pk2(v[j].x * rstd * g.x, v[j].y * rstd * g.y); w.y = pk2(v[j].z * rstd * g.z, v[j].w * rstd * g.w); o8[64 * j] = w; }
}

__device__ __forceinline__ void tile_gemm(float (&acc)[4][4], const bf16_t* A, int lda, const float* B, int ldb, int K, float* As, float* Bs) {
    const int tid = threadIdx.x, ty = tid >> 4, tx = tid & 15;
    for (int k0 = 0; k0 < K; k0 += 16) {
        { const int r = tid >> 2, kk = (tid & 3) * 4; const uint2 v = *(const uint2*)(A + (size_t)r * lda + k0 + kk);
          As[(kk + 0) * 68 + r] = bf2f(v.x & 0xffffu); As[(kk + 1) * 68 + r] = bf2f(v.x >> 16); As[(kk + 2) * 68 + r] = bf2f(v.y & 0xffffu); As[(kk + 3) * 68 + r] = bf2f(v.y >> 16); }
        { const int kk = tid >> 4, c = (tid & 15) * 4; *(float4*)&Bs[kk * 64 + c] = *(const float4*)(B + (size_t)(k0 + kk) * ldb + c); }
        __syncthreads();
#pragma unroll
        for (int kk = 0; kk < 16; ++kk) {
            const float4 a = *(const float4*)&As[kk * 68 + ty * 4]; const float4 b = *(const float4*)&Bs[kk * 64 + tx * 4];
            const float av[4] = {a.x, a.y, a.z, a.w}, bv[4] = {b.x, b.y, b.z, b.w};
#pragma unroll
            for (int i = 0; i < 4; ++i)
#pragma unroll
                for (int j = 0; j < 4; ++j) acc[i][j] += av[i] * bv[j];
        }
        __syncthreads();
    }
}

__global__ __launch_bounds__(256) void p1_naive(const bf16_t* __restrict__ XN, const float* __restrict__ Win, const float* qna, const float* kna, const float* qnb, const float* knb,
                                                const float* bmerge, bf16_t* QKV, bf16_t* GAB, bf16_t* Rb, bf16_t* G1b) {
    __shared__ float As[16 * 68], Bs[16 * 64];
    const int tn = blockIdx.x, row0 = blockIdx.y * 64, tid = threadIdx.x, ty = tid >> 4, tx = tid & 15;
    const bf16_t* A = XN + (size_t)row0 * DM;
    if (tn < 100) {
        const int col0 = tn * 64;
        float acc[4][4] = {};
        tile_gemm(acc, A, DM, Win + col0, NIN, DM, As, Bs);
        const float* gain = nullptr; float sc = 1.f;
        if (col0 < C_KA) { gain = qna; sc = QSCALE; } else if (col0 < C_VA) { gain = kna; } else if (col0 < C_QB) { } else if (col0 < C_KB) { gain = qnb; sc = QSCALE; } else if (col0 < C_VB) { gain = knb; }
#pragma unroll
        for (int i = 0; i < 4; ++i) {
            const int row = row0 + ty * 4 + i;
            float v[4] = {acc[i][0], acc[i][1], acc[i][2], acc[i][3]};
            if (gain) {
                float ss = v[0] * v[0] + v[1] * v[1] + v[2] * v[2] + v[3] * v[3];
                ss += __shfl_xor(ss, 1); ss += __shfl_xor(ss, 2); ss += __shfl_xor(ss, 4); ss += __shfl_xor(ss, 8);
                const float rstd = rsqrtf(ss * (1.f / 64.f) + EPS);
#pragma unroll
                for (int j = 0; j < 4; ++j) v[j] = v[j] * rstd * gain[tx * 4 + j] * sc;
            }
            uint2 w; w.x = pk2(v[0], v[1]); w.y = pk2(v[2], v[3]);
            if (col0 < C_GA) *(uint2*)(QKV + (size_t)row * QKV_LD + col0 + tx * 4) = w;
            else *(uint2*)(GAB + (size_t)row * 1024 + (col0 - C_GA) + tx * 4) = w;
        }
    } else {
        const int c0 = (tn - 100) * 64;
        float a0[4][4] = {}, a1[4][4] = {};
        tile_gemm(a0, A, DM, Win + C_MG + c0, NIN, DM, As, Bs);
        tile_gemm(a1, A, DM, Win + C_MG + 1024 + c0, NIN, DM, As, Bs);
#pragma unroll
        for (int i = 0; i < 4; ++i) {
            const int row = row0 + ty * 4 + i; float r[4], g[4];
#pragma unroll
            for (int j = 0; j < 4; ++j) { const int c = c0 + tx * 4 + j; const float g0 = 1.f / (1.f + __expf(-(a0[i][j] + bmerge[c]))), g1 = 1.f / (1.f + __expf(-(a1[i][j] + bmerge[1024 + c]))); r[j] = g0 / g1; g[j] = g1; }
            uint2 w; w.x = pk2(r[0], r[1]); w.y = pk2(r[2], r[3]); *(uint2*)(Rb + (size_t)row * 1024 + c0 + tx * 4) = w;
            w.x = pk2(g[0], g[1]); w.y = pk2(g[2], g[3]); *(uint2*)(G1b + (size_t)row * 1024 + c0 + tx * 4) = w;
        }
    }
}

__device__ __forceinline__ int t5_bucket(int rel) {
    const int n = rel < 0 ? -rel : rel; const int ret = rel > 0 ? 16 : 0;
    if (n < 8) return ret + n;
    int large = 8 + (int)(logf((float)n / 8.f) / 4.852030263919617f * 8.f);
    if (large > 15) large = 15;
    return ret + large;
}
template <int PROB>
__global__ __launch_bounds__(256) void attn_naive(bf16_t* QKV, const bf16_t* __restrict__ GAB, const float* __restrict__ rel_bias, const float* __restrict__ sink, float* LSE) {
    constexpr int dil = PROB == 0 ? 1 : (PROB == 1 ? 1 : (PROB == 2 ? 4 : 16));
    constexpr int HW = PROB == 0 ? 128 : 64;
    __shared__ float sb[2 * HW + 1];
    const int h = blockIdx.y, t = blockIdx.x * 256 + threadIdx.x, b = t / SEQ, s = t % SEQ;
    const int qcol = PROB == 0 ? C_QA + h * 64 : C_QB + (PROB - 1) * 512 + h * 64;
    const int kcol = PROB == 0 ? C_KA + (h >> 2) * 64 : C_KB + (PROB - 1) * 512 + h * 64;
    const int vcol = PROB == 0 ? C_VA + (h >> 2) * 64 : C_VB + (PROB - 1) * 512 + h * 64;
    const int bh = PROB == 0 ? h : 8 + (PROB - 1) * 8 + h;
    for (int j = threadIdx.x; j < 2 * HW + 1; j += 256) sb[j] = rel_bias[t5_bucket((j - HW) * dil) * 32 + bh] * LOG2E;
    __syncthreads();
    float q[64], o[64];
    { const uint4* qp = (const uint4*)(QKV + (size_t)t * QKV_LD + qcol);
#pragma unroll
      for (int c = 0; c < 8; ++c) { const uint4 v = qp[c]; q[8 * c + 0] = bf2f(v.x & 0xffffu); q[8 * c + 1] = bf2f(v.x >> 16); q[8 * c + 2] = bf2f(v.y & 0xffffu); q[8 * c + 3] = bf2f(v.y >> 16);
          q[8 * c + 4] = bf2f(v.z & 0xffffu); q[8 * c + 5] = bf2f(v.z >> 16); q[8 * c + 6] = bf2f(v.w & 0xffffu); q[8 * c + 7] = bf2f(v.w >> 16); } }
#pragma unroll
    for (int i = 0; i < 64; ++i) o[i] = 0.f;
    float m = -1e30f, l = 0.f;
    for (int j = -HW; j <= HW; ++j) {
        const int s2 = s + j * dil; if (s2 < 0 || s2 >= SEQ) continue;
        const size_t rowoff = (size_t)(b * SEQ + s2) * QKV_LD;
        const uint4* kp = (const uint4*)(QKV + rowoff + kcol);
        float dot = 0.f;
#pragma unroll
        for (int c = 0; c < 8; ++c) { const uint4 v = kp[c];
            dot += q[8 * c + 0] * bf2f(v.x & 0xffffu) + q[8 * c + 1] * bf2f(v.x >> 16) + q[8 * c + 2] * bf2f(v.y & 0xffffu) + q[8 * c + 3] * bf2f(v.y >> 16)
                 + q[8 * c + 4] * bf2f(v.z & 0xffffu) + q[8 * c + 5] * bf2f(v.z >> 16) + q[8 * c + 6] * bf2f(v.w & 0xffffu) + q[8 * c + 7] * bf2f(v.w >> 16); }
        const float sc = dot + sb[j + HW];
        const float mn = fmaxf(m, sc), a = exp2f(m - mn), p = exp2f(sc - mn);
        l = l * a + p; m = mn;
        const uint4* vp = (const uint4*)(QKV + rowoff + vcol);
#pragma unroll
        for (int c = 0; c < 8; ++c) { const uint4 v = vp[c];
            o[8 * c + 0] = o[8 * c + 0] * a + p * bf2f(v.x & 0xffffu); o[8 * c + 1] = o[8 * c + 1] * a + p * bf2f(v.x >> 16); o[8 * c + 2] = o[8 * c + 2] * a + p * bf2f(v.y & 0xffffu); o[8 * c + 3] = o[8 * c + 3] * a + p * bf2f(v.y >> 16);
            o[8 * c + 4] = o[8 * c + 4] * a + p * bf2f(v.z & 0xffffu); o[8 * c + 5] = o[8 * c + 5] * a + p * bf2f(v.z >> 16); o[8 * c + 6] = o[8 * c + 6] * a + p * bf2f(v.w & 0xffffu); o[8 * c + 7] = o[8 * c + 7] * a + p * bf2f(v.w >> 16); }
    }
    float inv;
    if (PROB == 0) { const float sk = sink[h] * LOG2E; const float mn = fmaxf(m, sk); const float a = exp2f(m - mn); const float lt = l * a + exp2f(sk - mn); inv = a / lt; }
    else { inv = 1.f / l; LSE[(size_t)(PROB - 1) * MTOK * 8 + (size_t)t * 8 + h] = m + log2f(l); }
    uint4* op = (uint4*)(QKV + (size_t)t * QKV_LD + qcol);
#pragma unroll
    for (int c = 0; c < 8; ++c) {
        float r[8];
#pragma unroll
        for (int e = 0; e < 8; ++e) r[e] = o[8 * c + e] * inv;
        if (PROB == 0) { const uint4 g = ((const uint4*)(GAB + (size_t)t * 1024 + h * 64))[c]; const unsigned gw[4] = {g.x, g.y, g.z, g.w};
#pragma unroll
            for (int e = 0; e < 8; ++e) { const float gv = bf2f((e & 1) ? (gw[e >> 1] >> 16) : (gw[e >> 1] & 0xffffu)); r[e] *= gv / (1.f + __expf(-gv)); } }
        uint4 w; w.x = pk2(r[0], r[1]); w.y = pk2(r[2], r[3]); w.z = pk2(r[4], r[5]); w.w = pk2(r[6], r[7]); op[c] = w;
    }
}

__global__ __launch_bounds__(256) void p2c_combine(bf16_t* QKV, const bf16_t* __restrict__ GAB, const float* __restrict__ LSE) {
    const int lane = threadIdx.x & 63, wave = threadIdx.x >> 6;
    const int t = blockIdx.x * 4 + wave, h = lane >> 3;
    float ls[3], mx = -1e30f;
#pragma unroll
    for (int g = 0; g < 3; ++g) { ls[g] = LSE[(size_t)g * MTOK * 8 + (size_t)t * 8 + h]; mx = fmaxf(mx, ls[g]); }
    float al[3], sum = 0.f;
#pragma unroll
    for (int g = 0; g < 3; ++g) { al[g] = exp2f(ls[g] - mx); sum += al[g]; }
    const float inv = 1.f / sum;
    float r[8] = {0.f, 0.f, 0.f, 0.f, 0.f, 0.f, 0.f, 0.f};
#pragma unroll
    for (int g = 0; g < 3; ++g) { const uint4 v = *(const uint4*)(QKV + (size_t)t * QKV_LD + C_QB + g * 512 + lane * 8); const unsigned w[4] = {v.x, v.y, v.z, v.w}; const float a = al[g] * inv;
#pragma unroll
        for (int e = 0; e < 8; ++e) r[e] += a * bf2f((e & 1) ? (w[e >> 1] >> 16) : (w[e >> 1] & 0xffffu)); }
    { const uint4 g = *(const uint4*)(GAB + (size_t)t * 1024 + 512 + lane * 8); const unsigned gw[4] = {g.x, g.y, g.z, g.w};
#pragma unroll
      for (int e = 0; e < 8; ++e) { const float gv = bf2f((e & 1) ? (gw[e >> 1] >> 16) : (gw[e >> 1] & 0xffffu)); r[e] *= gv / (1.f + __expf(-gv)); } }
    uint4 w; w.x = pk2(r[0], r[1]); w.y = pk2(r[2], r[3]); w.z = pk2(r[4], r[5]); w.w = pk2(r[6], r[7]);
    *(uint4*)(QKV + (size_t)t * QKV_LD + 512 + lane * 8) = w;
}

__global__ __launch_bounds__(256) void p3_naive(const bf16_t* __restrict__ QKV, const float* __restrict__ Wa, const float* __restrict__ Wb, const bf16_t* __restrict__ Rb, const bf16_t* __restrict__ G1b, bf16_t* MER) {
    __shared__ float As[16 * 68], Bs[16 * 64];
    const int col0 = blockIdx.x * 64, row0 = blockIdx.y * 64, tid = threadIdx.x, ty = tid >> 4, tx = tid & 15;
    float aa[4][4] = {}, ab[4][4] = {};
    tile_gemm(aa, QKV + (size_t)row0 * QKV_LD, QKV_LD, Wa + col0, 1024, 512, As, Bs);
    tile_gemm(ab, QKV + (size_t)row0 * QKV_LD + 512, QKV_LD, Wb + col0, 1024, 512, As, Bs);
#pragma unroll
    for (int i = 0; i < 4; ++i) {
        const int row = row0 + ty * 4 + i; float v[4];
        const uint2 rr = *(const uint2*)(Rb + (size_t)row * 1024 + col0 + tx * 4), gg = *(const uint2*)(G1b + (size_t)row * 1024 + col0 + tx * 4);
        const float rv[4] = {bf2f(rr.x & 0xffffu), bf2f(rr.x >> 16), bf2f(rr.y & 0xffffu), bf2f(rr.y >> 16)}, gv[4] = {bf2f(gg.x & 0xffffu), bf2f(gg.x >> 16), bf2f(gg.y & 0xffffu), bf2f(gg.y >> 16)};
#pragma unroll
        for (int j = 0; j < 4; ++j) v[j] = gv[j] * (rv[j] * aa[i][j] + ab[i][j]);
        uint2 w; w.x = pk2(v[0], v[1]); w.y = pk2(v[2], v[3]); *(uint2*)(MER + (size_t)row * 1024 + col0 + tx * 4) = w;
    }
}
__global__ __launch_bounds__(256) void p4_naive(const bf16_t* __restrict__ MER, const float* __restrict__ Wout, const float* __restrict__ x, float* out) {
    __shared__ float As[16 * 68], Bs[16 * 64];
    const int col0 = blockIdx.x * 64, row0 = blockIdx.y * 64, tid = threadIdx.x, ty = tid >> 4, tx = tid & 15;
    float acc[4][4] = {};
    tile_gemm(acc, MER + (size_t)row0 * 1024, 1024, Wout + col0, 1024, 1024, As, Bs);
#pragma unroll
    for (int i = 0; i < 4; ++i) { const size_t off = (size_t)(row0 + ty * 4 + i) * 1024 + col0 + tx * 4; const float4 xv = *(const float4*)(x + off);
        *(float4*)(out + off) = make_float4(xv.x + acc[i][0], xv.y + acc[i][1], xv.z + acc[i][2], xv.w + acc[i][3]); }
}


#include <hip/hip_cooperative_groups.h>
namespace cg = cooperative_groups;
#define LAS __attribute__((address_space(3)))
typedef short bf16x8 __attribute__((ext_vector_type(8)));
typedef float f32x4 __attribute__((ext_vector_type(4)));
typedef float f32x2 __attribute__((ext_vector_type(2)));
typedef unsigned u32x4 __attribute__((ext_vector_type(4)));
typedef float f32x16 __attribute__((ext_vector_type(16)));
typedef short s16x4 __attribute__((ext_vector_type(4)));
typedef __bf16 bf16x2_t __attribute__((ext_vector_type(2)));
__device__ __forceinline__ unsigned cvtpk(float lo, float hi) { f32x2 v = {lo, hi}; bf16x2_t b = __builtin_convertvector(v, bf16x2_t); return __builtin_bit_cast(unsigned, b); }
__device__ __forceinline__ float bflo(unsigned w) { return __builtin_bit_cast(float, w << 16); }
__device__ __forceinline__ float bfhi(unsigned w) { return __builtin_bit_cast(float, w & 0xffff0000u); }

namespace pg8 {
constexpr int BM = 256, BK = 64, HALF = 128, HTB = HALF * BK * 2, STAGE_BYTES = 8 * HTB, NXCD = 8, WGM = 8;
__host__ __device__ __forceinline__ int lds_byte(int r, int c) { const int st = (r >> 4) * 2 + (c >> 5), rr = r & 15, cc = c & 31, ob = rr * 64 + cc * 2; return st * 1024 + (ob ^ (((ob >> 9) & 1) << 5)); }
__host__ __device__ __forceinline__ void stage_rc(int b, int& R, int& C) { const int st = b / 1024, sb = b % 1024, swz = sb ^ (((sb >> 9) & 1) << 5); R = (st >> 1) * 16 + swz / 64; C = (st & 1) * 32 + (swz % 64) / 2; }
__host__ __device__ __forceinline__ int perm32(int rho) { const int n = rho >> 4, i = rho & 15; return 8 * (i >> 2) + 4 * n + (i & 3); }
struct Unit { int pm, pn; };
struct Gemm { const bf16_t* A; const bf16_t* Bt; int M, N, K, lda; };
struct StaticOrder {
    int nM, nN, nwg, G, c;
    __host__ __device__ void init(int M, int N, int G_, int c_) { nM = M / BM; nN = N / BM; nwg = nM * nN; G = G_; c = c_; }
    __host__ __device__ bool next(int i, Unit& u) const {
        const long L = (long)i * G + c; if (L >= nwg) return false;
        int wgid = (int)L; { const int q = nwg / NXCD, r = nwg % NXCD, xcd = wgid % NXCD, off = wgid / NXCD; wgid = (xcd < r ? xcd * (q + 1) : r * (q + 1) + (xcd - r) * q) + off; }
        const int nig = WGM * nN, gid = wgid / nig, fm = gid * WGM, gsz = (nM - fm) < WGM ? (nM - fm) : WGM;
        u.pm = fm + ((wgid % nig) % gsz); u.pn = (wgid % nig) / gsz; return true;
    }
};
template <class Epi, bool ALIGN_EPI>
__device__ __forceinline__ void gemm_phase(LAS unsigned char* lds, const Gemm g, const StaticOrder& S, const Epi& E) {
    const int tid = threadIdx.x, wid = __builtin_amdgcn_readfirstlane(tid >> 6), lane = tid & 63, wr = wid >> 2, wc = wid & 3, fr = lane & 15, fq = lane >> 4;
    const int K = g.K, nt = K / BK, lda = g.lda;
    unsigned voffA[2], voffB[2];
#pragma unroll
    for (int i = 0; i < 2; ++i) { int R, C; stage_rc(tid * 16 + i * 8192, R, C); const int Rb = Epi::PERM ? ((R & ~31) + perm32(R & 31)) : R;
        voffA[i] = (unsigned)(R * lda + C) * 2u; voffB[i] = (unsigned)(Rb * K + C) * 2u; }
    const size_t kstep = (size_t)(BK * 2);
    const size_t hstepA = (size_t)HALF * lda * 2, hstepB = (size_t)HALF * K * 2;
    const size_t tstepA = 2 * hstepA, tstepB = 2 * hstepB;
    const unsigned ldsw = (unsigned)wid * 1024u;
    const int aoff = lds_byte(wr * 64 + fr, fq * 8), boff = lds_byte(wc * 32 + fr, fq * 8);
#define PG8_SA(b, h) (((b) * 2 + (h)) * HTB)
#define PG8_SB(b, h) ((4 + (b) * 2 + (h)) * HTB)
#define PG8_STAGE(bufoff, gbase, voff) do { _Pragma("unroll") for (int _i = 0; _i < 2; ++_i) \
        __builtin_amdgcn_global_load_lds((const unsigned*)((const char*)(gbase) + (voff)[_i]), (LAS unsigned*)(lds + (bufoff) + ldsw + _i * 8192), 16, 0, 0); } while (0)
#define PG8_LDA(dst, b, h) do { _Pragma("unroll") for (int m = 0; m < 4; ++m) _Pragma("unroll") for (int k = 0; k < 2; ++k) dst[m][k] = *(const LAS bf16x8*)(lds + PG8_SA(b, h) + aoff + m * 2048 + k * 1024); } while (0)
#define PG8_LDB(dst, b, h) do { _Pragma("unroll") for (int n = 0; n < 2; ++n) _Pragma("unroll") for (int k = 0; k < 2; ++k) dst[n][k] = *(const LAS bf16x8*)(lds + PG8_SB(b, h) + boff + n * 2048 + k * 1024); } while (0)
#define PG8_MMA(ai, bj, At, Bt) do { __builtin_amdgcn_s_setprio(1); _Pragma("unroll") for (int m = 0; m < 4; ++m) _Pragma("unroll") for (int n = 0; n < 2; ++n) _Pragma("unroll") for (int k = 0; k < 2; ++k) \
        acc[ai][bj][m][n] = __builtin_amdgcn_mfma_f32_16x16x32_bf16(Bt[n][k], At[m][k], acc[ai][bj][m][n], 0, 0, 0); __builtin_amdgcn_s_setprio(0); } while (0)
#define PG8_WAIT_V(n) asm volatile("s_waitcnt vmcnt(" #n ")" ::: "memory")
#define PG8_WAIT_L(n) asm volatile("s_waitcnt lgkmcnt(" #n ")" ::: "memory")
#define PG8_BAR __builtin_amdgcn_s_barrier()
#define PG8_SCHED __builtin_amdgcn_sched_barrier(0)
    Unit cur, nxt; int ui = 0;
    if (!S.next(0, cur)) return;
    f32x4 acc[2][2][4][2];
#pragma unroll
    for (int a = 0; a < 2; ++a)
#pragma unroll
        for (int b = 0; b < 2; ++b)
#pragma unroll
            for (int m = 0; m < 4; ++m)
#pragma unroll
                for (int n = 0; n < 2; ++n) acc[a][b][m][n] = (f32x4){0.f, 0.f, 0.f, 0.f};
    bf16x8 At[4][2], B0[2][2], B1[2][2];
    const char* cA = (const char*)g.A + (size_t)cur.pm * tstepA; const char* cB = (const char*)g.Bt + (size_t)cur.pn * tstepB;
    PG8_STAGE(PG8_SB(0, 0), cB, voffB); PG8_STAGE(PG8_SB(0, 1), cB + hstepB, voffB); PG8_STAGE(PG8_SA(0, 0), cA, voffA); PG8_STAGE(PG8_SA(0, 1), cA + hstepA, voffA);
    if (wr == 1) PG8_BAR;
    PG8_WAIT_V(2); PG8_BAR;
    PG8_STAGE(PG8_SB(1, 0), cB + kstep, voffB); PG8_STAGE(PG8_SA(1, 0), cA + kstep, voffA); PG8_STAGE(PG8_SB(1, 1), cB + hstepB + kstep, voffB);
    PG8_WAIT_V(6); PG8_BAR;
    for (;;) {
        const bool has_next = S.next(ui + 1, nxt);
        const char* nA = has_next ? (const char*)g.A + (size_t)nxt.pm * tstepA : cA; const char* nB = has_next ? (const char*)g.Bt + (size_t)nxt.pn * tstepB : cB;
        for (int t = 0; t < nt; t += 2) {
            if constexpr (Epi::HAS_MID) { if (t == nt / 2) E.mid(acc, cur, wr, wc, fr, fq); }
            const bool last = (t == nt - 2);
            const char* a1 = cA + (size_t)(t + 1) * kstep;
            const char* a2 = last ? nA : cA + (size_t)(t + 2) * kstep; const char* b2 = last ? nB : cB + (size_t)(t + 2) * kstep;
            const char* a3 = a2 + kstep; const char* b3 = b2 + kstep;
            PG8_LDB(B0, 0, 0); PG8_LDB(B1, 0, 1); PG8_SCHED; PG8_LDA(At, 0, 0); PG8_STAGE(PG8_SA(1, 1), a1 + hstepA, voffA);
            PG8_WAIT_V(8); PG8_WAIT_L(0); PG8_BAR; PG8_MMA(0, 0, At, B0); PG8_MMA(0, 1, At, B1); PG8_BAR; PG8_SCHED;
            PG8_LDA(At, 0, 1); PG8_STAGE(PG8_SB(0, 0), b2, voffB); PG8_STAGE(PG8_SB(0, 1), b2 + hstepB, voffB); PG8_STAGE(PG8_SA(0, 0), a2, voffA);
            PG8_WAIT_V(8); PG8_WAIT_L(0); PG8_BAR; PG8_MMA(1, 0, At, B0); PG8_MMA(1, 1, At, B1); PG8_BAR; PG8_SCHED;
            PG8_LDB(B0, 1, 0); PG8_LDB(B1, 1, 1); PG8_SCHED; PG8_LDA(At, 1, 0); PG8_STAGE(PG8_SA(0, 1), a2 + hstepA, voffA);
            PG8_WAIT_V(8); PG8_WAIT_L(0); PG8_BAR; PG8_MMA(0, 0, At, B0); PG8_MMA(0, 1, At, B1); PG8_BAR; PG8_SCHED;
            PG8_LDA(At, 1, 1); PG8_STAGE(PG8_SB(1, 0), b3, voffB); PG8_STAGE(PG8_SB(1, 1), b3 + hstepB, voffB); PG8_STAGE(PG8_SA(1, 0), a3, voffA);
            PG8_WAIT_V(8); PG8_WAIT_L(0); PG8_BAR; PG8_MMA(1, 0, At, B0); PG8_MMA(1, 1, At, B1); PG8_BAR; PG8_SCHED;
        }
        if constexpr (ALIGN_EPI) { if (wr == 0) PG8_BAR; }
        E(acc, cur, wr, wc, fr, fq);
        if (!has_next) break;
#pragma unroll
        for (int a = 0; a < 2; ++a)
#pragma unroll
            for (int b = 0; b < 2; ++b)
#pragma unroll
                for (int m = 0; m < 4; ++m)
#pragma unroll
                    for (int n = 0; n < 2; ++n) acc[a][b][m][n] = (f32x4){0.f, 0.f, 0.f, 0.f};
        cur = nxt; cA = nA; cB = nB; ++ui;
        if constexpr (ALIGN_EPI) { if (wr == 1) PG8_BAR; }
    }
    PG8_WAIT_V(0);
    if constexpr (!ALIGN_EPI) { if (wr == 0) PG8_BAR; }
    PG8_BAR;
#undef PG8_SA
#undef PG8_SB
#undef PG8_STAGE
#undef PG8_LDA
#undef PG8_LDB
#undef PG8_MMA
#undef PG8_WAIT_V
#undef PG8_WAIT_L
#undef PG8_BAR
#undef PG8_SCHED
}
}

struct EpiP1 {
    static constexpr bool PERM = true, HAS_MID = false;
    bf16_t* QKV; bf16_t* GAB; bf16_t* Rb; bf16_t* G1b; const float *qna, *kna, *qnb, *knb, *bm;
    __device__ __forceinline__ void operator()(const f32x4 (&acc)[2][2][4][2], const pg8::Unit& u, int wr, int wc, int fr, int fq) const {
        const int row0 = u.pm * 256 + wr * 64 + fr;
        if (u.pn < 25) {
            const int hc0 = u.pn * 256 + wc * 64;
            const float* gain = nullptr; float sc = 1.f;
            if (hc0 < C_KA) { gain = qna; sc = QSCALE; } else if (hc0 < C_VA) { gain = kna; } else if (hc0 < C_QB) { } else if (hc0 < C_KB) { gain = qnb; sc = QSCALE; } else if (hc0 < C_VB) { gain = knb; }
            f32x4 gv[2][2];
#pragma unroll
            for (int bj = 0; bj < 2; ++bj)
#pragma unroll
                for (int n = 0; n < 2; ++n) gv[bj][n] = gain ? *(const f32x4*)(gain + 32 * bj + 8 * fq + 4 * n) * sc : (f32x4){1.f, 1.f, 1.f, 1.f};
            bf16_t* base; int ld;
            if (hc0 < C_GA) { base = QKV + hc0; ld = QKV_LD; } else { base = GAB + (hc0 - C_GA); ld = 1024; }
#pragma unroll
            for (int ai = 0; ai < 2; ++ai)
#pragma unroll
                for (int m = 0; m < 4; ++m) {
                    float rstd = 1.f;
                    if (gain) {
                        float ss = 0.f;
#pragma unroll
                        for (int bj = 0; bj < 2; ++bj)
#pragma unroll
                            for (int n = 0; n < 2; ++n) { const f32x4 x = acc[ai][bj][m][n]; ss += (x[0] * x[0] + x[1] * x[1]) + (x[2] * x[2] + x[3] * x[3]); }
                        ss += __shfl_xor(ss, 16); ss += __shfl_xor(ss, 32);
                        rstd = rsqrtf(ss * (1.f / 64.f) + EPS);
                    }
                    bf16_t* rowp = base + (size_t)(row0 + ai * 128 + m * 16) * ld + 8 * fq;
#pragma unroll
                    for (int bj = 0; bj < 2; ++bj) { const f32x4 v0 = acc[ai][bj][m][0] * gv[bj][0] * rstd, v1 = acc[ai][bj][m][1] * gv[bj][1] * rstd;
                        u32x4 w; w.x = cvtpk(v0[0], v0[1]); w.y = cvtpk(v0[2], v0[3]); w.z = cvtpk(v1[0], v1[1]); w.w = cvtpk(v1[2], v1[3]);
                        *(u32x4*)(rowp + 32 * bj) = w; }
                }
        } else {
            const int c0 = 128 * (u.pn - 25) + wc * 32 + 8 * fq;
            f32x4 b0[2], b1[2];
#pragma unroll
            for (int n = 0; n < 2; ++n) { b0[n] = *(const f32x4*)(bm + c0 + 4 * n); b1[n] = *(const f32x4*)(bm + 1024 + c0 + 4 * n); }
#pragma unroll
            for (int ai = 0; ai < 2; ++ai)
#pragma unroll
                for (int m = 0; m < 4; ++m) {
                    const size_t off = (size_t)(row0 + ai * 128 + m * 16) * 1024 + c0;
                    float r[8], g[8];
#pragma unroll
                    for (int n = 0; n < 2; ++n)
#pragma unroll
                        for (int j = 0; j < 4; ++j) { const float z0 = acc[ai][0][m][n][j] + b0[n][j], z1 = acc[ai][1][m][n][j] + b1[n][j];
                            const float e0 = 1.f + __expf(-z0), e1 = 1.f + __expf(-z1); const float g1 = __builtin_amdgcn_rcpf(e1);
                            g[4 * n + j] = g1; r[4 * n + j] = e1 * __builtin_amdgcn_rcpf(e0); }
                    u32x4 w; w.x = cvtpk(r[0], r[1]); w.y = cvtpk(r[2], r[3]); w.z = cvtpk(r[4], r[5]); w.w = cvtpk(r[6], r[7]); *(u32x4*)(Rb + off) = w;
                    w.x = cvtpk(g[0], g[1]); w.y = cvtpk(g[2], g[3]); w.z = cvtpk(g[4], g[5]); w.w = cvtpk(g[6], g[7]); *(u32x4*)(G1b + off) = w;
                }
        }
    }
};
struct EpiP4 {
    static constexpr bool PERM = true, HAS_MID = true;
    const bf16_t* Rb; const bf16_t* G1b; bf16_t* MER;
    __device__ __forceinline__ void mid(f32x4 (&acc)[2][2][4][2], const pg8::Unit& u, int wr, int wc, int fr, int fq) const {
        const int row0 = u.pm * 256 + wr * 64 + fr, col0 = u.pn * 256 + wc * 32 + 8 * fq;
        const bf16_t* rb = Rb + (size_t)row0 * 1024 + col0; asm volatile("" : "+v"(rb));
#pragma unroll
        for (int ai = 0; ai < 2; ++ai)
#pragma unroll
            for (int m = 0; m < 4; ++m)
#pragma unroll
                for (int bj = 0; bj < 2; ++bj) { const u32x4 w = *(const __attribute__((address_space(1))) u32x4*)(rb + (size_t)(ai * 128 + m * 16) * 1024 + bj * 128);
                    acc[ai][bj][m][0] *= (f32x4){bflo(w.x), bfhi(w.x), bflo(w.y), bfhi(w.y)}; acc[ai][bj][m][1] *= (f32x4){bflo(w.z), bfhi(w.z), bflo(w.w), bfhi(w.w)};
                    if (bj == 1 && (m & 1)) asm volatile("" ::: "memory"); }
    }
    __device__ __forceinline__ void operator()(const f32x4 (&acc)[2][2][4][2], const pg8::Unit& u, int wr, int wc, int fr, int fq) const {
        const int row0 = u.pm * 256 + wr * 64 + fr, col0 = u.pn * 256 + wc * 32 + 8 * fq;
#pragma unroll
        for (int ai = 0; ai < 2; ++ai)
#pragma unroll
            for (int m = 0; m < 4; ++m)
#pragma unroll
                for (int bj = 0; bj < 2; ++bj) { const size_t off = (size_t)(row0 + ai * 128 + m * 16) * 1024 + col0 + bj * 128; const u32x4 w = *(const u32x4*)(G1b + off);
                    const f32x4 v0 = acc[ai][bj][m][0] * (f32x4){bflo(w.x), bfhi(w.x), bflo(w.y), bfhi(w.y)}, v1 = acc[ai][bj][m][1] * (f32x4){bflo(w.z), bfhi(w.z), bflo(w.w), bfhi(w.w)};
                    u32x4 o; o.x = cvtpk(v0[0], v0[1]); o.y = cvtpk(v0[2], v0[3]); o.z = cvtpk(v1[0], v1[1]); o.w = cvtpk(v1[2], v1[3]); *(u32x4*)(MER + off) = o;
                    if (bj == 1 && (m & 1)) asm volatile("" ::: "memory"); }
    }
};
struct EpiP5 {
    static constexpr bool PERM = false, HAS_MID = false;
    const float* x; float* out;
    __device__ __forceinline__ void operator()(const f32x4 (&acc)[2][2][4][2], const pg8::Unit& u, int wr, int wc, int fr, int fq) const {
        const int row0 = u.pm * 256 + wr * 64 + fr, col0 = u.pn * 256 + wc * 32 + 4 * fq;
#pragma unroll
        for (int ai = 0; ai < 2; ++ai)
#pragma unroll
            for (int m = 0; m < 4; ++m) {
#pragma unroll
                for (int bj = 0; bj < 2; ++bj)
#pragma unroll
                    for (int n = 0; n < 2; ++n) { const size_t off = (size_t)(row0 + ai * 128 + m * 16) * 1024 + col0 + bj * 128 + n * 16; *(f32x4*)(out + off) = *(const f32x4*)(x + off) + acc[ai][bj][m][n]; }
                if (m & 1) asm volatile("" ::: "memory");
            }
    }
};

constexpr int RING_BYTES = 131072, TAB_OFF = RING_BYTES, WSF_OFF = TAB_OFF + 6144, LDS_BYTES = WSF_OFF + 2048 + 1024;

__device__ __forceinline__ void p0_transpose_item(const float* W, int N, bf16_t* WT, int ldt, int koff, int drow0, LAS float* scr, int k0, int n0, int lane) {
#pragma unroll 8
    for (int i = 0; i < 32; ++i) { const int kk = 2 * i + (lane >> 5); scr[kk * 33 + (lane & 31)] = W[(size_t)(k0 + kk) * N + n0 + (lane & 31)]; }
    asm volatile("s_waitcnt lgkmcnt(0)" ::: "memory");
    const int c = lane & 7;
#pragma unroll
    for (int j = 0; j < 4; ++j) { const int n = (lane >> 3) + 8 * j; const LAS float* s = scr + (8 * c) * 33 + n;
        u32x4 o; o.x = pk2(s[0 * 33], s[1 * 33]); o.y = pk2(s[2 * 33], s[3 * 33]); o.z = pk2(s[4 * 33], s[5 * 33]); o.w = pk2(s[6 * 33], s[7 * 33]);
        *(u32x4*)(WT + (size_t)(drow0 + n) * ldt + koff + k0 + 8 * c) = o; }
    asm volatile("s_waitcnt lgkmcnt(0)" ::: "memory");
}
__device__ __forceinline__ int win_dest_row(int n0) {
    if (n0 < C_MG) { const int pn = n0 >> 8, rem = n0 & 255; return 256 * pn + 128 * ((rem >> 5) & 1) + 32 * (rem >> 6); }
    const int mc = n0 - C_MG, bj = mc >> 10, c = mc & 1023; return 256 * (25 + (c >> 7)) + 128 * bj + 32 * ((c & 127) >> 5);
}
struct Ptrs {
    const float *x, *gain, *Win, *qna, *kna, *qnb, *knb, *sink, *relb, *Wa, *Wb, *bm, *Wout; float* out;
    bf16_t *WinT, *WabT, *WoutT, *XN, *MER, *GAB, *QKV, *Rb, *G1b; float* LSE;
};
__device__ __forceinline__ void p0_prologue(LAS unsigned char* lds, const Ptrs& P, int vcu, int G, int wave, int lane) {
    LAS float* scr = (LAS float*)(lds + wave * 16384);
    const int gw = vcu * 8 + wave, NGW = G * 8;
    constexpr int I_IN = 16 * (NIN / 32), I_A = 8 * 32, I_B = 8 * 32, I_O = 16 * 32, NITEMS = I_IN + I_A + I_B + I_O;
    for (int it = gw; it < NITEMS; it += NGW) {
        int r = it;
        if (r < I_IN) { const int kb = r / (NIN / 32), nb = r % (NIN / 32); p0_transpose_item(P.Win, NIN, P.WinT, 1024, 0, win_dest_row(32 * nb), scr, 64 * kb, 32 * nb, lane); continue; } r -= I_IN;
        if (r < I_A) { const int kb = r >> 5, nb = r & 31; p0_transpose_item(P.Wa, 1024, P.WabT, 1024, 0, 32 * nb, scr, 64 * kb, 32 * nb, lane); continue; } r -= I_A;
        if (r < I_B) { const int kb = r >> 5, nb = r & 31; p0_transpose_item(P.Wb, 1024, P.WabT, 1024, 512, 32 * nb, scr, 64 * kb, 32 * nb, lane); continue; } r -= I_B;
        { const int kb = r >> 5, nb = r & 31; p0_transpose_item(P.Wout, 1024, P.WoutT, 1024, 0, 32 * nb, scr, 64 * kb, 32 * nb, lane); }
    }
    for (int row = gw; row < MTOK; row += NGW) {
        const float4* xr = (const float4*)(P.x + (size_t)row * DM) + lane;
        float4 v[4]; float s = 0.f;
#pragma unroll
        for (int j = 0; j < 4; ++j) { v[j] = xr[64 * j]; s += (v[j].x * v[j].x + v[j].y * v[j].y) + (v[j].z * v[j].z + v[j].w * v[j].w); }
#pragma unroll
        for (int o = 1; o < 64; o <<= 1) s += __shfl_xor(s, o);
        const float rstd = rsqrtf(s * (1.f / DM) + EPS);
        uint2* o8 = (uint2*)(P.XN + (size_t)row * DM) + lane;
#pragma unroll
        for (int j = 0; j < 4; ++j) { const float4 g = ((const float4*)P.gain)[lane + 64 * j];
            uint2 w; w.x = cvtpk(v[j].x * rstd * g.x, v[j].y * rstd * g.y); w.y = cvtpk(v[j].z * rstd * g.z, v[j].w * rstd * g.w); o8[64 * j] = w; }
    }
}

namespace att {
constexpr int OST_OFF = 65536;
__device__ __forceinline__ int crow(int r, int hi) { return (r & 3) + 8 * (r >> 2) + 4 * hi; }
__device__ __forceinline__ void glds16(const void* gsrc, unsigned lds_dst) { unsigned keep;
    asm volatile("s_mov_b32 %0, m0\n\ts_mov_b32 m0, %2\n\ts_nop 0\n\tglobal_load_lds_dwordx4 %1, off\n\ts_mov_b32 m0, %0" : "=&s"(keep) : "v"(gsrc), "s"(lds_dst) : "memory"); }
__device__ __forceinline__ void pv(f32x16* o, int vb, bf16x8 pa0, bf16x8 pa1, bf16x8 pa2, bf16x8 pa3) {
#pragma unroll
    for (int d0 = 0; d0 < 2; ++d0) { s16x4 lo[4], hi[4];
#pragma unroll
        for (int ks = 0; ks < 4; ++ks) {
            asm volatile("ds_read_b64_tr_b16 %0,%1 offset:%c2" : "=&v"(lo[ks]) : "v"(vb), "i"(d0 * 4096 + ks * 1024) : "memory");
            asm volatile("ds_read_b64_tr_b16 %0,%1 offset:%c2" : "=&v"(hi[ks]) : "v"(vb), "i"(d0 * 4096 + ks * 1024 + 512) : "memory"); }
        asm volatile("s_waitcnt lgkmcnt(0)" ::: "memory"); __builtin_amdgcn_sched_barrier(0);
#define PK(k) (bf16x8){lo[k][0], lo[k][1], lo[k][2], lo[k][3], hi[k][0], hi[k][1], hi[k][2], hi[k][3]}
        o[d0] = __builtin_amdgcn_mfma_f32_32x32x16_bf16(pa0, PK(0), o[d0], 0, 0, 0);
        o[d0] = __builtin_amdgcn_mfma_f32_32x32x16_bf16(pa1, PK(1), o[d0], 0, 0, 0);
        o[d0] = __builtin_amdgcn_mfma_f32_32x32x16_bf16(pa2, PK(2), o[d0], 0, 0, 0);
        o[d0] = __builtin_amdgcn_mfma_f32_32x32x16_bf16(pa3, PK(3), o[d0], 0, 0, 0);
#undef PK
    }
}
__device__ __forceinline__ void attn_phase(LAS unsigned char* lds, const Ptrs& P, int vcu) {
    const int tid = threadIdx.x, lane = tid & 63, r32 = lane & 31, hi = lane >> 5;
    const int wid = __builtin_amdgcn_readfirstlane(tid >> 6), hh = wid >> 1, half = wid & 1;
    const unsigned lds0 = (unsigned)(uintptr_t)lds;
    LAS float* tabs = (LAS float*)(lds + TAB_OFF);
    LAS float* wsf = (LAS float*)(lds + WSF_OFF) + wid * 64;
    bf16_t* QKV = P.QKV;
    int tab_key = -1;
    for (int ui = 0; ui < 16; ++ui) {
        const int prob = ui >> 2, j = 4 * vcu + (ui & 3);
        int d, dsh, HW, NT, L, b, c, qblk, qcol, kcol0, vcol0, kstride, bh0, key;
        if (prob == 0) { dsh = 0; HW = 128; NT = 5; qblk = j & 63; const int kvh = (j >> 6) & 1; b = j >> 7; c = 0;
            qcol = C_QA + (4 * kvh + hh) * 64; kcol0 = C_KA + kvh * 64; vcol0 = C_VA + kvh * 64; kstride = 0; bh0 = 4 * kvh; key = kvh; }
        else { const int g = prob - 1; dsh = 2 * g; HW = 64; NT = 3; const int nqs = 6 - dsh; qblk = j & ((1 << nqs) - 1); int rest = j >> nqs; const int hquad = rest & 1; rest >>= 1; c = rest & ((1 << dsh) - 1); b = rest >> dsh;
            qcol = C_QB + g * 512 + (4 * hquad + hh) * 64; kcol0 = C_KB + g * 512 + 4 * hquad * 64; vcol0 = C_VB + g * 512 + 4 * hquad * 64; kstride = 64; bh0 = 8 + 8 * g + 4 * hquad; key = 2 + 2 * g + hquad; }
        d = 1 << dsh; L = SEQ >> dsh;
        if (key != tab_key) {
            __syncthreads();
            for (int e = tid; e < 4 * 384; e += 512) { const int th = e / 384, rel = (e % 384) - 191; const int arel = rel < 0 ? -rel : rel;
                tabs[e] = (arel <= HW) ? P.relb[t5_bucket(rel * d) * 32 + bh0 + th] * LOG2E : -1e30f; }
            __syncthreads(); tab_key = key;
        }
        const int nslot = prob == 0 ? 1 : 4, myslot = prob == 0 ? 0 : hh;
        const size_t rowb = (size_t)b * SEQ;
        const int mq = 64 * qblk + 32 * half;
        bf16_t* Qw = QKV + (rowb + (size_t)(mq << dsh) + c) * QKV_LD + qcol;
        const size_t rstep = (size_t)QKV_LD << dsh;
        bf16x8 qr[4];
#pragma unroll
        for (int d0 = 0; d0 < 4; ++d0) qr[d0] = *(const bf16x8*)(Qw + (size_t)r32 * rstep + d0 * 16 + hi * 8);
        float mrun = -1e30f, lrun = 0.f; f32x16 o[2]; o[0] = f32x16{}; o[1] = f32x16{};
        const LAS float* tab = tabs + hh * 384;
        for (int i = 0; i < NT; ++i) {
            const int tile_lo = 64 * (qblk + i) - HW;
            if (tile_lo < 0 || tile_lo >= L) continue;
            asm volatile("s_waitcnt lgkmcnt(0)" ::: "memory"); __syncthreads();
            for (int s = 0; s < nslot; ++s) {
                const bf16_t* ks = QKV + (rowb + (size_t)((tile_lo + lane) << dsh) + c) * QKV_LD + kcol0 + s * kstride + wid * 8;
                glds16(ks, (unsigned)__builtin_amdgcn_readfirstlane(lds0 + s * 16384 + wid * 1024));
                const bf16_t* vs = QKV + (rowb + (size_t)((tile_lo + 16 * (wid & 3) + (lane >> 2)) << dsh) + c) * QKV_LD + vcol0 + s * kstride + (wid >> 2) * 32 + (lane & 3) * 8;
                glds16(vs, (unsigned)__builtin_amdgcn_readfirstlane(lds0 + s * 16384 + 8192 + wid * 1024));
            }
            asm volatile("s_waitcnt vmcnt(0)" ::: "memory"); __syncthreads();
            f32x16 p0 = f32x16{}, p1 = f32x16{};
            { const LAS unsigned char* kb = lds + myslot * 16384 + hi * 1024 + r32 * 16;
#pragma unroll
              for (int d0 = 0; d0 < 4; ++d0) { const bf16x8 k0 = *(const LAS bf16x8*)(kb + d0 * 2048), k1 = *(const LAS bf16x8*)(kb + d0 * 2048 + 512);
                  p0 = __builtin_amdgcn_mfma_f32_32x32x16_bf16(k0, qr[d0], p0, 0, 0, 0); p1 = __builtin_amdgcn_mfma_f32_32x32x16_bf16(k1, qr[d0], p1, 0, 0, 0); } }
            { const LAS float* tb = tab + (191 - HW + 64 * i + 4 * hi - 32 * half - r32);
#pragma unroll
              for (int r = 0; r < 16; ++r) { p0[r] += tb[(r & 3) + 8 * (r >> 2)]; p1[r] += tb[32 + (r & 3) + 8 * (r >> 2)]; } }
            float rm = fmaxf(p0[0], p1[0]);
#pragma unroll
            for (int r = 1; r < 16; ++r) rm = fmaxf(rm, fmaxf(p0[r], p1[r]));
            { auto rr = __builtin_amdgcn_permlane32_swap(__float_as_uint(rm), __float_as_uint(rm), false, false); rm = fmaxf(__uint_as_float(rr[0]), __uint_as_float(rr[1])); }
            const float mn = fmaxf(mrun, rm), alpha = __builtin_amdgcn_exp2f(mrun - mn); mrun = mn;
            float ps = 0.f;
#pragma unroll
            for (int r = 0; r < 16; ++r) { p0[r] = __builtin_amdgcn_exp2f(p0[r] - mn); p1[r] = __builtin_amdgcn_exp2f(p1[r] - mn); ps += p0[r] + p1[r]; }
            lrun = lrun * alpha + ps;
            if (hi == 0) wsf[r32] = alpha;
            asm volatile("s_waitcnt lgkmcnt(0)" ::: "memory");
#pragma unroll
            for (int r = 0; r < 16; ++r) { const float f = wsf[crow(r, hi)]; o[0][r] *= f; o[1][r] *= f; }
            u32x4 pw0, pw1, pw2, pw3;
            pw0 = (u32x4){cvtpk(p0[0], p0[1]), cvtpk(p0[2], p0[3]), cvtpk(p0[4], p0[5]), cvtpk(p0[6], p0[7])};
            pw1 = (u32x4){cvtpk(p0[8], p0[9]), cvtpk(p0[10], p0[11]), cvtpk(p0[12], p0[13]), cvtpk(p0[14], p0[15])};
            pw2 = (u32x4){cvtpk(p1[0], p1[1]), cvtpk(p1[2], p1[3]), cvtpk(p1[4], p1[5]), cvtpk(p1[6], p1[7])};
            pw3 = (u32x4){cvtpk(p1[8], p1[9]), cvtpk(p1[10], p1[11]), cvtpk(p1[12], p1[13]), cvtpk(p1[14], p1[15])};
            const int vb = (int)(lds0 + myslot * 16384 + 8192) + ((lane >> 4) & 1) * 32 + (lane & 3) * 8 + (4 * hi + ((lane & 15) >> 2)) * 64;
            asm volatile("s_waitcnt lgkmcnt(0)" ::: "memory"); __builtin_amdgcn_sched_barrier(0);
            pv(o, vb, __builtin_bit_cast(bf16x8, pw0), __builtin_bit_cast(bf16x8, pw1), __builtin_bit_cast(bf16x8, pw2), __builtin_bit_cast(bf16x8, pw3));
        }
        { auto rr = __builtin_amdgcn_permlane32_swap(__float_as_uint(lrun), __float_as_uint(lrun), false, false); lrun = __uint_as_float(rr[0]) + __uint_as_float(rr[1]); }
        float inv;
        if (prob == 0) { const float sk = P.sink[bh0 + hh] * LOG2E, mn = fmaxf(mrun, sk), a = __builtin_amdgcn_exp2f(mrun - mn); inv = a / (lrun * a + __builtin_amdgcn_exp2f(sk - mn)); }
        else { inv = 1.f / lrun; if (hi == 0) P.LSE[(size_t)(prob - 1) * MTOK * 8 + (rowb + (size_t)((mq + r32) << dsh) + c) * 8 + (bh0 - 8 * prob) + hh] = mrun + __log2f(lrun); }
        if (hi == 0) wsf[32 + r32] = inv;
        asm volatile("s_waitcnt lgkmcnt(0)" ::: "memory");
        LAS bf16_t* stg = (LAS bf16_t*)(lds + OST_OFF) + wid * 2048;
#pragma unroll
        for (int r = 0; r < 16; ++r) { const int orow = crow(r, hi); const float f = wsf[32 + orow];
            stg[orow * 64 + r32] = (bf16_t)f2bf(o[0][r] * f); stg[orow * 64 + 32 + r32] = (bf16_t)f2bf(o[1][r] * f); }
        asm volatile("s_waitcnt lgkmcnt(0)" ::: "memory");
#pragma unroll
        for (int i = 0; i < 4; ++i) { const int row = i * 8 + (lane >> 3), ch = lane & 7; u32x4 v = *(const LAS u32x4*)(stg + row * 64 + ch * 8);
            const size_t grow = rowb + (size_t)((mq + row) << dsh) + c;
            if (prob == 0) { const u32x4 g = *(const u32x4*)(P.GAB + grow * 1024 + (bh0 + hh) * 64 + ch * 8); const unsigned gw[4] = {g.x, g.y, g.z, g.w}; unsigned vw[4] = {v.x, v.y, v.z, v.w};
#pragma unroll
                for (int e = 0; e < 4; ++e) { const float g0 = bflo(gw[e]), g1 = bfhi(gw[e]); const float s0 = g0 / (1.f + __expf(-g0)), s1 = g1 / (1.f + __expf(-g1)); vw[e] = cvtpk(bflo(vw[e]) * s0, bfhi(vw[e]) * s1); }
                v = (u32x4){vw[0], vw[1], vw[2], vw[3]}; }
            *(u32x4*)(QKV + grow * QKV_LD + qcol + ch * 8) = v; }
        asm volatile("s_waitcnt lgkmcnt(0)" ::: "memory");
    }
    __syncthreads();
}
}

__device__ __forceinline__ void p3_combine(const Ptrs& P, int vcu, int G, int wave, int lane) {
    const int h = lane >> 3;
    for (int t = vcu * 8 + wave; t < MTOK; t += G * 8) {
        float ls[3], mx = -1e30f;
#pragma unroll
        for (int g = 0; g < 3; ++g) { ls[g] = P.LSE[(size_t)g * MTOK * 8 + (size_t)t * 8 + h]; mx = fmaxf(mx, ls[g]); }
        float al[3], sum = 0.f;
#pragma unroll
        for (int g = 0; g < 3; ++g) { al[g] = exp2f(ls[g] - mx); sum += al[g]; }
        const float inv = 1.f / sum;
        float r[8] = {0.f, 0.f, 0.f, 0.f, 0.f, 0.f, 0.f, 0.f};
#pragma unroll
        for (int g = 0; g < 3; ++g) { const u32x4 v = *(const u32x4*)(P.QKV + (size_t)t * QKV_LD + C_QB + g * 512 + lane * 8); const unsigned w[4] = {v.x, v.y, v.z, v.w}; const float a = al[g] * inv;
#pragma unroll
            for (int e = 0; e < 4; ++e) { r[2 * e] += a * bflo(w[e]); r[2 * e + 1] += a * bfhi(w[e]); } }
        { const u32x4 g = *(const u32x4*)(P.GAB + (size_t)t * 1024 + 512 + lane * 8); const unsigned gw[4] = {g.x, g.y, g.z, g.w};
#pragma unroll
          for (int e = 0; e < 4; ++e) { const float g0 = bflo(gw[e]), g1 = bfhi(gw[e]); r[2 * e] *= g0 / (1.f + __expf(-g0)); r[2 * e + 1] *= g1 / (1.f + __expf(-g1)); } }
        u32x4 w; w.x = cvtpk(r[0], r[1]); w.y = cvtpk(r[2], r[3]); w.z = cvtpk(r[4], r[5]); w.w = cvtpk(r[6], r[7]);
        *(u32x4*)(P.QKV + (size_t)t * QKV_LD + 512 + lane * 8) = w;
    }
}

struct Args { const float* in[13]; float* out; unsigned char* ws; int ph_lo, ph_hi; };
__global__ void __launch_bounds__(512, 2) mega_fwd(Args a) {
    extern __shared__ __attribute__((aligned(16))) unsigned char lds_raw[];
    LAS unsigned char* lds = (LAS unsigned char*)lds_raw;
    cg::grid_group grid = cg::this_grid();
    const int tid = threadIdx.x, lane = tid & 63, wave = __builtin_amdgcn_readfirstlane(tid >> 6);
    const int G = gridDim.x, bx = blockIdx.x, vcu = (G % 8 == 0) ? (bx % 8) * (G / 8) + bx / 8 : bx;
    Ptrs P;
    P.x = a.in[0]; P.gain = a.in[1]; P.Win = a.in[2]; P.qna = a.in[3]; P.kna = a.in[4]; P.qnb = a.in[5]; P.knb = a.in[6]; P.sink = a.in[7]; P.relb = a.in[8];
    P.Wa = a.in[9]; P.Wb = a.in[10]; P.bm = a.in[11]; P.Wout = a.in[12]; P.out = a.out;
    unsigned char* ws = a.ws;
    P.WinT = (bf16_t*)(ws + WS_WIN); P.WabT = (bf16_t*)(ws + WS_WAB); P.WoutT = (bf16_t*)(ws + WS_WOUT); P.XN = (bf16_t*)(ws + WS_XN); P.MER = P.XN;
    P.GAB = (bf16_t*)(ws + WS_GAB); P.QKV = (bf16_t*)(ws + WS_QKV); P.LSE = (float*)(ws + WS_LSE); P.Rb = (bf16_t*)a.out; P.G1b = P.Rb + (size_t)MTOK * 1024;
    const int lo = a.ph_lo, hi = a.ph_hi;
#ifndef PH_EN
#define PH_EN 0x3f
#endif
#define IN(k) (((PH_EN >> (k)) & 1) && lo <= (k) && (k) < hi)
#define BOTH(k) (IN(k) && IN((k) + 1))
    if (IN(0)) { p0_prologue(lds, P, vcu, G, wave, lane); if (BOTH(0)) grid.sync(); }
    if (IN(1)) {
        pg8::Gemm g{P.XN, P.WinT, MTOK, NIN, 1024, 1024}; pg8::StaticOrder S; S.init(MTOK, NIN, G, bx);
        EpiP1 E{P.QKV, P.GAB, P.Rb, P.G1b, P.qna, P.kna, P.qnb, P.knb, P.bm};
        pg8::gemm_phase<EpiP1, true>(lds, g, S, E);
        if (BOTH(1)) grid.sync();
    }
    if (IN(2)) { att::attn_phase(lds, P, vcu); if (BOTH(2)) grid.sync(); }
    if (IN(3)) { p3_combine(P, vcu, G, wave, lane); if (BOTH(3)) grid.sync(); }
    if (IN(4)) {
        pg8::Gemm g{P.QKV, P.WabT, MTOK, 1024, 1024, QKV_LD}; pg8::StaticOrder S; S.init(MTOK, 1024, G, bx);
        EpiP4 E{P.Rb, P.G1b, P.MER};
        pg8::gemm_phase<EpiP4, true>(lds, g, S, E);
        if (BOTH(4)) grid.sync();
    }
    if (IN(5)) {
        pg8::Gemm g{P.MER, P.WoutT, MTOK, 1024, 1024, 1024}; pg8::StaticOrder S; S.init(MTOK, 1024, G, bx);
        EpiP5 E{P.x, P.out};
        pg8::gemm_phase<EpiP5, true>(lds, g, S, E);
    }
#undef IN
#undef BOTH
}

#ifndef MEGA_MASK
#define MEGA_MASK 0x3f
#endif
#ifndef ONE_LAUNCH
#define ONE_LAUNCH 1
#endif
extern "C" void kernel_launch(void* const* d_in, const int* in_sizes, int n_in, void* d_out, int out_size, void* d_ws, size_t ws_size, hipStream_t stream) {
    static int grid = 0;
    if (grid == 0) {
        if (n_in != 13 || out_size != MTOK * DM || ws_size < WS_END) { fprintf(stderr, "kernel_launch: unexpected shapes (n_in %d out %d ws %zu)\n", n_in, out_size, ws_size); grid = -1; return; }
        int dev = 0, cus = 0, per_cu = 0;
        if (hipGetDevice(&dev) != hipSuccess || hipDeviceGetAttribute(&cus, hipDeviceAttributeMultiprocessorCount, dev) != hipSuccess) { grid = -1; return; }
        if (hipFuncSetAttribute((const void*)mega_fwd, hipFuncAttributeMaxDynamicSharedMemorySize, LDS_BYTES) != hipSuccess) { fprintf(stderr, "kernel_launch: hipFuncSetAttribute failed\n"); grid = -1; return; }
        if (hipOccupancyMaxActiveBlocksPerMultiprocessor(&per_cu, (const void*)mega_fwd, 512, LDS_BYTES) != hipSuccess || per_cu < 1) { fprintf(stderr, "kernel_launch: occupancy query says %d blocks per CU\n", per_cu); (void)hipGetLastError(); grid = -1; return; }
        grid = cus;
    }
    if (grid < 0) return;
    Args a{};
    for (int i = 0; i < 13; ++i) a.in[i] = (const float*)d_in[i];
    a.out = (float*)d_out; a.ws = (unsigned char*)d_ws;
#if ONE_LAUNCH
    a.ph_lo = 0; a.ph_hi = 6;
    void* args[] = {&a};
    hipError_t e = hipLaunchCooperativeKernel((const void*)mega_fwd, dim3(grid), dim3(512), args, LDS_BYTES, stream);
    if (e != hipSuccess) fprintf(stderr, "cooperative launch failed: %s (grid %d)\n", hipGetErrorString(e), grid);
#else
    const float* x = a.in[0]; unsigned char* ws = a.ws;
    bf16_t* XN = (bf16_t*)(ws + WS_XN); bf16_t* MER = XN; bf16_t* GAB = (bf16_t*)(ws + WS_GAB); bf16_t* QKV = (bf16_t*)(ws + WS_QKV); float* LSE = (float*)(ws + WS_LSE);
    bf16_t* Rb = (bf16_t*)d_out; bf16_t* G1b = Rb + (size_t)MTOK * 1024;
    for (int ph = 0; ph < 6; ++ph) {
        if ((MEGA_MASK >> ph) & 1) { a.ph_lo = ph; a.ph_hi = ph + 1; hipLaunchKernelGGL(mega_fwd, dim3(grid), dim3(512), LDS_BYTES, stream, a); continue; }
        switch (ph) {
        case 0: p0_naive<<<MTOK / 4, 256, 0, stream>>>(x, a.in[1], XN); break;
        case 1: p1_naive<<<dim3(116, MTOK / 64), 256, 0, stream>>>(XN, a.in[2], a.in[3], a.in[4], a.in[5], a.in[6], a.in[11], QKV, GAB, Rb, G1b); break;
        case 2: attn_naive<0><<<dim3(MTOK / 256, 8), 256, 0, stream>>>(QKV, GAB, a.in[8], a.in[7], LSE); attn_naive<1><<<dim3(MTOK / 256, 8), 256, 0, stream>>>(QKV, GAB, a.in[8], a.in[7], LSE);
                attn_naive<2><<<dim3(MTOK / 256, 8), 256, 0, stream>>>(QKV, GAB, a.in[8], a.in[7], LSE); attn_naive<3><<<dim3(MTOK / 256, 8), 256, 0, stream>>>(QKV, GAB, a.in[8], a.in[7], LSE); break;
        case 3: p2c_combine<<<MTOK / 4, 256, 0, stream>>>(QKV, GAB, LSE); break;
        case 4: p3_naive<<<dim3(16, MTOK / 64), 256, 0, stream>>>(QKV, a.in[9], a.in[10], Rb, G1b, MER); break;
        case 5: p4_naive<<<dim3(16, MTOK / 64), 256, 0, stream>>>(MER, a.in[12], x, (float*)d_out); break;
        }
    }
#endif
}
```

```cpp
#define MEGA_MASK 0x3f
#define ONE_LAUNCH 1
#include <hip/hip_runtime.h>
#include <cstdint>
#include <cstdio>

typedef unsigned short bf16_t;
constexpr int BATCH = 8, SEQ = 4096, DM = 1024, MTOK = BATCH * SEQ;
constexpr int NIN = 8448;
constexpr int C_QA = 0, C_KA = 512, C_VA = 640, C_QB = 768, C_KB = 2304, C_VB = 3840, C_GA = 5376, C_GB = 5888, C_MG = 6400;
constexpr int QKV_LD = 5376;
constexpr float LOG2E = 1.4426950408889634f;
constexpr float QSCALE = 0.125f * LOG2E;
constexpr float EPS = 1e-6f;

constexpr size_t MiB = (size_t)1 << 20;
constexpr size_t WS_CTL = 0, WS_WIN = 1 * MiB, WS_WAB = 18 * MiB, WS_WOUT = 20 * MiB, WS_LSE = 22 * MiB, WS_XN = 26 * MiB, WS_GAB = 90 * MiB, WS_QKV = 154 * MiB, WS_END = 490 * MiB;

__device__ __forceinline__ unsigned f2bf(float f) { unsigned u = __builtin_bit_cast(unsigned, f); return (u + 0x7fffu + ((u >> 16) & 1u)) >> 16; }
__device__ __forceinline__ float bf2f(unsigned b) { return __builtin_bit_cast(float, b << 16); }
__device__ __forceinline__ unsigned pk2(float lo, float hi) { return f2bf(lo) | (f2bf(hi) << 16); }

__global__ __launch_bounds__(256) void p0_naive(const float* __restrict__ x, const float* __restrict__ gain, bf16_t* __restrict__ XN) {
    const int lane = threadIdx.x & 63, wave = threadIdx.x >> 6;
    const int row = blockIdx.x * 4 + wave;
    const float4* xr = (const float4*)(x + (size_t)row * DM) + lane;
    float4 v[4]; float s = 0.f;
#pragma unroll
    for (int j = 0; j < 4; ++j) { v[j] = xr[64 * j]; s += v[j].x * v[j].x + v[j].y * v[j].y + v[j].z * v[j].z + v[j].w * v[j].w; }
#pragma unroll
    for (int o = 1; o < 64; o <<= 1) s += __shfl_xor(s, o);
    const float rstd = rsqrtf(s * (1.f / DM) + EPS);
    uint2* o8 = (uint2*)(XN + (size_t)row * DM) + lane;
#pragma unroll
    for (int j = 0; j < 4; ++j) { const float4 g = ((const float4*)gain)[lane + 64 * j];
        uint2 w; w.x = pk2(v[j].x * rstd * g.x, v[j].y * rstd * g.y); w.y = pk2(v[j].z * rstd * g.z, v[j].w * rstd * g.w); o8[64 * j] = w; }
}

__device__ __forceinline__ void tile_gemm(float (&acc)[4][4], const bf16_t* A, int lda, const float* B, int ldb, int K, float* As, float* Bs) {
    const int tid = threadIdx.x, ty = tid >> 4, tx = tid & 15;
    for (int k0 = 0; k0 < K; k0 += 16) {
        { const int r = tid >> 2, kk = (tid & 3) * 4; const uint2 v = *(const uint2*)(A + (size_t)r * lda + k0 + kk);
          As[(kk + 0) * 68 + r] = bf2f(v.x & 0xffffu); As[(kk + 1) * 68 + r] = bf2f(v.x >> 16); As[(kk + 2) * 68 + r] = bf2f(v.y & 0xffffu); As[(kk + 3) * 68 + r] = bf2f(v.y >> 16); }
        { const int kk = tid >> 4, c = (tid & 15) * 4; *(float4*)&Bs[kk * 64 + c] = *(const float4*)(B + (size_t)(k0 + kk) * ldb + c); }
        __syncthreads();
#pragma unroll
        for (int kk = 0; kk < 16; ++kk) {
            const float4 a = *(const float4*)&As[kk * 68 + ty * 4]; const float4 b = *(const float4*)&Bs[kk * 64 + tx * 4];
            const float av[4] = {a.x, a.y, a.z, a.w}, bv[4] = {b.x, b.y, b.z, b.w};
#pragma unroll
            for (int i = 0; i < 4; ++i)
#pragma unroll
                for (int j = 0; j < 4; ++j) acc[i][j] += av[i] * bv[j];
        }
        __syncthreads();
    }
}

__global__ __launch_bounds__(256) void p1_naive(const bf16_t* __restrict__ XN, const float* __restrict__ Win, const float* qna, const float* kna, const float* qnb, const float* knb,
                                                const float* bmerge, bf16_t* QKV, bf16_t* GAB, bf16_t* Rb, bf16_t* G1b) {
    __shared__ float As[16 * 68], Bs[16 * 64];
    const int tn = blockIdx.x, row0 = blockIdx.y * 64, tid = threadIdx.x, ty = tid >> 4, tx = tid & 15;
    const bf16_t* A = XN + (size_t)row0 * DM;
    if (tn < 100) {
        const int col0 = tn * 64;
        float acc[4][4] = {};
        tile_gemm(acc, A, DM, Win + col0, NIN, DM, As, Bs);
        const float* gain = nullptr; float sc = 1.f;
        if (col0 < C_KA) { gain = qna; sc = QSCALE; } else if (col0 < C_VA) { gain = kna; } else if (col0 < C_QB) { } else if (col0 < C_KB) { gain = qnb; sc = QSCALE; } else if (col0 < C_VB) { gain = knb; }
#pragma unroll
        for (int i = 0; i < 4; ++i) {
            const int row = row0 + ty * 4 + i;
            float v[4] = {acc[i][0], acc[i][1], acc[i][2], acc[i][3]};
            if (gain) {
                float ss = v[0] * v[0] + v[1] * v[1] + v[2] * v[2] + v[3] * v[3];
                ss += __shfl_xor(ss, 1); ss += __shfl_xor(ss, 2); ss += __shfl_xor(ss, 4); ss += __shfl_xor(ss, 8);
                const float rstd = rsqrtf(ss * (1.f / 64.f) + EPS);
#pragma unroll
                for (int j = 0; j < 4; ++j) v[j] = v[j] * rstd * gain[tx * 4 + j] * sc;
            }
            uint2 w; w.x = pk2(v[0], v[1]); w.y = pk2(v[2], v[3]);
            if (col0 < C_GA) *(uint2*)(QKV + (size_t)row * QKV_LD + col0 + tx * 4) = w;
            else *(uint2*)(GAB + (size_t)row * 1024 + (col0 - C_GA) + tx * 4) = w;
        }
    } else {
        const int c0 = (tn - 100) * 64;
        float a0[4][4] = {}, a1[4][4] = {};
        tile_gemm(a0, A, DM, Win + C_MG + c0, NIN, DM, As, Bs);
        tile_gemm(a1, A, DM, Win + C_MG + 1024 + c0, NIN, DM, As, Bs);
#pragma unroll
        for (int i = 0; i < 4; ++i) {
            const int row = row0 + ty * 4 + i; float r[4], g[4];
#pragma unroll
            for (int j = 0; j < 4; ++j) { const int c = c0 + tx * 4 + j; const float g0 = 1.f / (1.f + __expf(-(a0[i][j] + bmerge[c]))), g1 = 1.f / (1.f + __expf(-(a1[i][j] + bmerge[1024 + c]))); r[j] = g0 / g1; g[j] = g1; }
            uint2 w; w.x = pk2(r[0], r[1]); w.y = pk2(r[2], r[3]); *(uint2*)(Rb + (size_t)row * 1024 + c0 + tx * 4) = w;
            w.x = pk2(g[0], g[1]); w.y = pk2(g[2], g[3]); *(uint2*)(G1b + (size_t)row * 1024 + c0 + tx * 4) = w;
        }
    }
}

__device__ __forceinline__ int t5_bucket(int rel) {
    const int n = rel < 0 ? -rel : rel; const int ret = rel > 0 ? 16 : 0;
    if (n < 8) return ret + n;
    int large = 8 + (int)(logf((float)n / 8.f) / 4.852030263919617f * 8.f);
    if (large > 15) large = 15;
    return ret + large;
}
template <int PROB>
__global__ __launch_bounds__(256) void attn_naive(bf16_t* QKV, const bf16_t* __restrict__ GAB, const float* __restrict__ rel_bias, const float* __restrict__ sink, float* LSE) {
    constexpr int dil = PROB == 0 ? 1 : (PROB == 1 ? 1 : (PROB == 2 ? 4 : 16));
    constexpr int HW = PROB == 0 ? 128 : 64;
    __shared__ float sb[2 * HW + 1];
    const int h = blockIdx.y, t = blockIdx.x * 256 + threadIdx.x, b = t / SEQ, s = t % SEQ;
    const int qcol = PROB == 0 ? C_QA + h * 64 : C_QB + (PROB - 1) * 512 + h * 64;
    const int kcol = PROB == 0 ? C_KA + (h >> 2) * 64 : C_KB + (PROB - 1) * 512 + h * 64;
    const int vcol = PROB == 0 ? C_VA + (h >> 2) * 64 : C_VB + (PROB - 1) * 512 + h * 64;
    const int bh = PROB == 0 ? h : 8 + (PROB - 1) * 8 + h;
    for (int j = threadIdx.x; j < 2 * HW + 1; j += 256) sb[j] = rel_bias[t5_bucket((j - HW) * dil) * 32 + bh] * LOG2E;
    __syncthreads();
    float q[64], o[64];
    { const uint4* qp = (const uint4*)(QKV + (size_t)t * QKV_LD + qcol);
#pragma unroll
      for (int c = 0; c < 8; ++c) { const uint4 v = qp[c]; q[8 * c + 0] = bf2f(v.x & 0xffffu); q[8 * c + 1] = bf2f(v.x >> 16); q[8 * c + 2] = bf2f(v.y & 0xffffu); q[8 * c + 3] = bf2f(v.y >> 16);
          q[8 * c + 4] = bf2f(v.z & 0xffffu); q[8 * c + 5] = bf2f(v.z >> 16); q[8 * c + 6] = bf2f(v.w & 0xffffu); q[8 * c + 7] = bf2f(v.w >> 16); } }
#pragma unroll
    for (int i = 0; i < 64; ++i) o[i] = 0.f;
    float m = -1e30f, l = 0.f;
    for (int j = -HW; j <= HW; ++j) {
        const int s2 = s + j * dil; if (s2 < 0 || s2 >= SEQ) continue;
        const size_t rowoff = (size_t)(b * SEQ + s2) * QKV_LD;
        const uint4* kp = (const uint4*)(QKV + rowoff + kcol);
        float dot = 0.f;
#pragma unroll
        for (int c = 0; c < 8; ++c) { const uint4 v = kp[c];
            dot += q[8 * c + 0] * bf2f(v.x & 0xffffu) + q[8 * c + 1] * bf2f(v.x >> 16) + q[8 * c + 2] * bf2f(v.y & 0xffffu) + q[8 * c + 3] * bf2f(v.y >> 16)
                 + q[8 * c + 4] * bf2f(v.z & 0xffffu) + q[8 * c + 5] * bf2f(v.z >> 16) + q[8 * c + 6] * bf2f(v.w & 0xffffu) + q[8 * c + 7] * bf2f(v.w >> 16); }
        const float sc = dot + sb[j + HW];
        const float mn = fmaxf(m, sc), a = exp2f(m - mn), p = exp2f(sc - mn);
        l = l * a + p; m = mn;
        const uint4* vp = (const uint4*)(QKV + rowoff + vcol);
#pragma unroll
        for (int c = 0; c < 8; ++c) { const uint4 v = vp[c];
            o[8 * c + 0] = o[8 * c + 0] * a + p * bf2f(v.x & 0xffffu); o[8 * c + 1] = o[8 * c + 1] * a + p * bf2f(v.x >> 16); o[8 * c + 2] = o[8 * c + 2] * a + p * bf2f(v.y & 0xffffu); o[8 * c + 3] = o[8 * c + 3] * a + p * bf2f(v.y >> 16);
            o[8 * c + 4] = o[8 * c + 4] * a + p * bf2f(v.z & 0xffffu); o[8 * c + 5] = o[8 * c + 5] * a + p * bf2f(v.z >> 16); o[8 * c + 6] = o[8 * c + 6] * a + p * bf2f(v.w & 0xffffu); o[8 * c + 7] = o[8 * c + 7] * a + p * bf2f(v.w >> 16); }
    }
    float inv;
    if (PROB == 0) { const float sk = sink[h] * LOG2E; const float mn = fmaxf(m, sk); const float a = exp2f(m - mn); const float lt = l * a + exp2f(sk - mn); inv = a / lt; }
    else { inv = 1.f / l; LSE[(size_t)(PROB - 1) * MTOK * 8 + (size_t)t * 8 + h] = m + log2f(l); }
    uint4* op = (uint4*)(QKV + (size_t)t * QKV_LD + qcol);
#pragma unroll
    for (int c = 0; c < 8; ++c) {
        float r[8];
#pragma unroll
        for (int e = 0; e < 8; ++e) r[e] = o[8 * c + e] * inv;
        if (PROB == 0) { const uint4 g = ((const uint4*)(GAB + (size_t)t * 1024 + h * 64))[c]; const unsigned gw[4] = {g.x, g.y, g.z, g.w};
#pragma unroll
            for (int e = 0; e < 8; ++e) { const float gv = bf2f((e & 1) ? (gw[e >> 1] >> 16) : (gw[e >> 1] & 0xffffu)); r[e] *= gv / (1.f + __expf(-gv)); } }
        uint4 w; w.x = pk2(r[0], r[1]); w.y = pk2(r[2], r[3]); w.z = pk2(r[4], r[5]); w.w = pk2(r[6], r[7]); op[c] = w;
    }
}

__global__ __launch_bounds__(256) void p2c_combine(bf16_t* QKV, const bf16_t* __restrict__ GAB, const float* __restrict__ LSE) {
    const int lane = threadIdx.x & 63, wave = threadIdx.x >> 6;
    const int t = blockIdx.x * 4 + wave, h = lane >> 3;
    float ls[3], mx = -1e30f;
#pragma unroll
    for (int g = 0; g < 3; ++g) { ls[g] = LSE[(size_t)g * MTOK * 8 + (size_t)t * 8 + h]; mx = fmaxf(mx, ls[g]); }
    float al[3], sum = 0.f;
#pragma unroll
    for (int g = 0; g < 3; ++g) { al[g] = exp2f(ls[g] - mx); sum += al[g]; }
    const float inv = 1.f / sum;
    float r[8] = {0.f, 0.f, 0.f, 0.f, 0.f, 0.f, 0.f, 0.f};
#pragma unroll
    for (int g = 0; g < 3; ++g) { const uint4 v = *(const uint4*)(QKV + (size_t)t * QKV_LD + C_QB + g * 512 + lane * 8); const unsigned w[4] = {v.x, v.y, v.z, v.w}; const float a = al[g] * inv;
#pragma unroll
        for (int e = 0; e < 8; ++e) r[e] += a * bf2f((e & 1) ? (w[e >> 1] >> 16) : (w[e >> 1] & 0xffffu)); }
    { const uint4 g = *(const uint4*)(GAB + (size_t)t * 1024 + 512 + lane * 8); const unsigned gw[4] = {g.x, g.y, g.z, g.w};
#pragma unroll
      for (int e = 0; e < 8; ++e) { const float gv = bf2f((e & 1) ? (gw[e >> 1] >> 16) : (gw[e >> 1] & 0xffffu)); r[e] *= gv / (1.f + __expf(-gv)); } }
    uint4 w; w.x = pk2(r[0], r[1]); w.y = pk2(r[2], r[3]); w.z = pk2(r[4], r[5]); w.w = pk2(r[6], r[7]);
    *(uint4*)(QKV + (size_t)t * QKV_LD + 512 + lane * 8) = w;
}

__global__ __launch_bounds__(256) void p3_naive(const bf16_t* __restrict__ QKV, const float* __restrict__ Wa, const float* __restrict__ Wb, const bf16_t* __restrict__ Rb, const bf16_t* __restrict__ G1b, bf16_t* MER) {
    __shared__ float As[16 * 68], Bs[16 * 64];
    const int col0 = blockIdx.x * 64, row0 = blockIdx.y * 64, tid = threadIdx.x, ty = tid >> 4, tx = tid & 15;
    float aa[4][4] = {}, ab[4][4] = {};
    tile_gemm(aa, QKV + (size_t)row0 * QKV_LD, QKV_LD, Wa + col0, 1024, 512, As, Bs);
    tile_gemm(ab, QKV + (size_t)row0 * QKV_LD + 512, QKV_LD, Wb + col0, 1024, 512, As, Bs);
#pragma unroll
    for (int i = 0; i < 4; ++i) {
        const int row = row0 + ty * 4 + i; float v[4];
        const uint2 rr = *(const uint2*)(Rb + (size_t)row * 1024 + col0 + tx * 4), gg = *(const uint2*)(G1b + (size_t)row * 1024 + col0 + tx * 4);
        const float rv[4] = {bf2f(rr.x & 0xffffu), bf2f(rr.x >> 16), bf2f(rr.y & 0xffffu), bf2f(rr.y >> 16)}, gv[4] = {bf2f(gg.x & 0xffffu), bf2f(gg.x >> 16), bf2f(gg.y & 0xffffu), bf2f(gg.y >> 16)};
#pragma unroll
        for (int j = 0; j < 4; ++j) v[j] = gv[j] * (rv[j] * aa[i][j] + ab[i][j]);
        uint2 w; w.x = pk2(v[0], v[1]); w.y = pk2(v[2], v[3]); *(uint2*)(MER + (size_t)row * 1024 + col0 + tx * 4) = w;
    }
}
__global__ __launch_bounds__(256) void p4_naive(const bf16_t* __restrict__ MER, const float* __restrict__ Wout, const float* __restrict__ x, float* out) {
    __shared__ float As[16 * 68], Bs[16 * 64];
    const int col0 = blockIdx.x * 64, row0 = blockIdx.y * 64, tid = threadIdx.x, ty = tid >> 4, tx = tid & 15;
    float acc[4][4] = {};
    tile_gemm(acc, MER + (size_t)row0 * 1024, 1024, Wout + col0, 1024, 1024, As, Bs);
#pragma unroll
    for (int i = 0; i < 4; ++i) { const size_t off = (size_t)(row0 + ty * 4 + i) * 1024 + col0 + tx * 4; const float4 xv = *(const float4*)(x + off);
        *(float4*)(out + off) = make_float4(xv.x + acc[i][0], xv.y + acc[i][1], xv.z + acc[i][2], xv.w + acc[i][3]); }
}


#include <hip/hip_cooperative_groups.h>
namespace cg = cooperative_groups;
#define LAS __attribute__((address_space(3)))
typedef short bf16x8 __attribute__((ext_vector_type(8)));
typedef float f32x4 __attribute__((ext_vector_type(4)));
typedef float f32x2 __attribute__((ext_vector_type(2)));
typedef unsigned u32x4 __attribute__((ext_vector_type(4)));
typedef float f32x16 __attribute__((ext_vector_type(16)));
typedef short s16x4 __attribute__((ext_vector_type(4)));
typedef __bf16 bf16x2_t __attribute__((ext_vector_type(2)));
__device__ __forceinline__ unsigned cvtpk(float lo, float hi) { f32x2 v = {lo, hi}; bf16x2_t b = __builtin_convertvector(v, bf16x2_t); return __builtin_bit_cast(unsigned, b); }
__device__ __forceinline__ float bflo(unsigned w) { return __builtin_bit_cast(float, w << 16); }
__device__ __forceinline__ float bfhi(unsigned w) { return __builtin_bit_cast(float, w & 0xffff0000u); }


#ifndef PROBE
#define PROBE 0
#endif
#ifndef PROBE_MASK
#define PROBE_MASK 0
#endif
struct Prof { unsigned long long tl; unsigned acc[32]; };
#if PROBE
#define STAMP(pf, k) do { const unsigned long long _t = __builtin_amdgcn_s_memrealtime(); (pf).acc[k] += (unsigned)(_t - (pf).tl); (pf).tl = _t; } while (0)
#else
#define STAMP(pf, k) do { } while (0)
#endif
namespace pg8 {
constexpr int BM = 256, BK = 64, HALF = 128, HTB = HALF * BK * 2, STAGE_BYTES = 8 * HTB, NXCD = 8, WGM = 8;
__host__ __device__ __forceinline__ int lds_byte(int r, int c) { const int st = (r >> 4) * 2 + (c >> 5), rr = r & 15, cc = c & 31, ob = rr * 64 + cc * 2; return st * 1024 + (ob ^ (((ob >> 9) & 1) << 5)); }
__host__ __device__ __forceinline__ void stage_rc(int b, int& R, int& C) { const int st = b / 1024, sb = b % 1024, swz = sb ^ (((sb >> 9) & 1) << 5); R = (st >> 1) * 16 + swz / 64; C = (st & 1) * 32 + (swz % 64) / 2; }
__host__ __device__ __forceinline__ int perm32(int rho) { const int n = rho >> 4, i = rho & 15; return 8 * (i >> 2) + 4 * n + (i & 3); }
struct Unit { int pm, pn; };
struct Gemm { const bf16_t* A; const bf16_t* Bt; int M, N, K, lda; };
struct StaticOrder {
    int nM, nN, nwg, G, c;
    __host__ __device__ void init(int M, int N, int G_, int c_) { nM = M / BM; nN = N / BM; nwg = nM * nN; G = G_; c = c_; }
    __host__ __device__ bool next(int i, Unit& u) const {
        const long L = (long)i * G + c; if (L >= nwg) return false;
        int wgid = (int)L; { const int q = nwg / NXCD, r = nwg % NXCD, xcd = wgid % NXCD, off = wgid / NXCD; wgid = (xcd < r ? xcd * (q + 1) : r * (q + 1) + (xcd - r) * q) + off; }
        const int nig = WGM * nN, gid = wgid / nig, fm = gid * WGM, gsz = (nM - fm) < WGM ? (nM - fm) : WGM;
        u.pm = fm + ((wgid % nig) % gsz); u.pn = (wgid % nig) / gsz; return true;
    }
};
template <class Epi, bool ALIGN_EPI, int PB>
__device__ __forceinline__ void gemm_phase(LAS unsigned char* lds, const Gemm g, const StaticOrder& S, const Epi& E, Prof& pf) {
    const int tid = threadIdx.x, wid = __builtin_amdgcn_readfirstlane(tid >> 6), lane = tid & 63, wr = wid >> 2, wc = wid & 3, fr = lane & 15, fq = lane >> 4;
    const int K = g.K, nt = K / BK, lda = g.lda;
    unsigned voffA[2], voffB[2];
#pragma unroll
    for (int i = 0; i < 2; ++i) { int R, C; stage_rc(tid * 16 + i * 8192, R, C); const int Rb = Epi::PERM ? ((R & ~31) + perm32(R & 31)) : R;
        voffA[i] = (unsigned)(R * lda + C) * 2u; voffB[i] = (unsigned)(Rb * K + C) * 2u; }
    const size_t kstep = (size_t)(BK * 2);
    const size_t hstepA = (size_t)HALF * lda * 2, hstepB = (size_t)HALF * K * 2;
    const size_t tstepA = 2 * hstepA, tstepB = 2 * hstepB;
    const unsigned ldsw = (unsigned)wid * 1024u;
    const int aoff = lds_byte(wr * 64 + fr, fq * 8), boff = lds_byte(wc * 32 + fr, fq * 8);
#define PG8_SA(b, h) (((b) * 2 + (h)) * HTB)
#define PG8_SB(b, h) ((4 + (b) * 2 + (h)) * HTB)
#define PG8_STAGE(bufoff, gbase, voff) do { _Pragma("unroll") for (int _i = 0; _i < 2; ++_i) \
        __builtin_amdgcn_global_load_lds((const unsigned*)((const char*)(gbase) + (voff)[_i]), (LAS unsigned*)(lds + (bufoff) + ldsw + _i * 8192), 16, 0, 0); } while (0)
#define PG8_LDA(dst, b, h) do { _Pragma("unroll") for (int m = 0; m < 4; ++m) _Pragma("unroll") for (int k = 0; k < 2; ++k) dst[m][k] = *(const LAS bf16x8*)(lds + PG8_SA(b, h) + aoff + m * 2048 + k * 1024); } while (0)
#define PG8_LDB(dst, b, h) do { _Pragma("unroll") for (int n = 0; n < 2; ++n) _Pragma("unroll") for (int k = 0; k < 2; ++k) dst[n][k] = *(const LAS bf16x8*)(lds + PG8_SB(b, h) + boff + n * 2048 + k * 1024); } while (0)
#define PG8_MMA(ai, bj, At, Bt) do { __builtin_amdgcn_s_setprio(1); _Pragma("unroll") for (int m = 0; m < 4; ++m) _Pragma("unroll") for (int n = 0; n < 2; ++n) _Pragma("unroll") for (int k = 0; k < 2; ++k) \
        acc[ai][bj][m][n] = __builtin_amdgcn_mfma_f32_16x16x32_bf16(Bt[n][k], At[m][k], acc[ai][bj][m][n], 0, 0, 0); __builtin_amdgcn_s_setprio(0); } while (0)
#define PG8_WAIT_V(n) asm volatile("s_waitcnt vmcnt(" #n ")" ::: "memory")
#define PG8_WAIT_L(n) asm volatile("s_waitcnt lgkmcnt(" #n ")" ::: "memory")
#define PG8_BAR __builtin_amdgcn_s_barrier()
#define PG8_SCHED __builtin_amdgcn_sched_barrier(0)
    Unit cur, nxt; int ui = 0;
    if (!S.next(0, cur)) return;
    f32x4 acc[2][2][4][2];
#pragma unroll
    for (int a = 0; a < 2; ++a)
#pragma unroll
        for (int b = 0; b < 2; ++b)
#pragma unroll
            for (int m = 0; m < 4; ++m)
#pragma unroll
                for (int n = 0; n < 2; ++n) acc[a][b][m][n] = (f32x4){0.f, 0.f, 0.f, 0.f};
    bf16x8 At[4][2], B0[2][2], B1[2][2];
    const char* cA = (const char*)g.A + (size_t)cur.pm * tstepA; const char* cB = (const char*)g.Bt + (size_t)cur.pn * tstepB;
    PG8_STAGE(PG8_SB(0, 0), cB, voffB); PG8_STAGE(PG8_SB(0, 1), cB + hstepB, voffB); PG8_STAGE(PG8_SA(0, 0), cA, voffA); PG8_STAGE(PG8_SA(0, 1), cA + hstepA, voffA);
    if (wr == 1) PG8_BAR;
    PG8_WAIT_V(2); PG8_BAR;
    PG8_STAGE(PG8_SB(1, 0), cB + kstep, voffB); PG8_STAGE(PG8_SA(1, 0), cA + kstep, voffA); PG8_STAGE(PG8_SB(1, 1), cB + hstepB + kstep, voffB);
    PG8_WAIT_V(6); PG8_BAR;
    for (;;) {
        const bool has_next = S.next(ui + 1, nxt);
        const char* nA = has_next ? (const char*)g.A + (size_t)nxt.pm * tstepA : cA; const char* nB = has_next ? (const char*)g.Bt + (size_t)nxt.pn * tstepB : cB;
        for (int t = 0; t < nt; t += 2) {
            if constexpr (Epi::HAS_MID) { if (t == nt / 2) { STAMP(pf, PB); E.mid(acc, cur, wr, wc, fr, fq); STAMP(pf, PB + 3); } }
            const bool last = (t == nt - 2);
            const char* a1 = cA + (size_t)(t + 1) * kstep;
            const char* a2 = last ? nA : cA + (size_t)(t + 2) * kstep; const char* b2 = last ? nB : cB + (size_t)(t + 2) * kstep;
            const char* a3 = a2 + kstep; const char* b3 = b2 + kstep;
            PG8_LDB(B0, 0, 0); PG8_LDB(B1, 0, 1); PG8_SCHED; PG8_LDA(At, 0, 0); PG8_STAGE(PG8_SA(1, 1), a1 + hstepA, voffA);
            PG8_WAIT_V(8); PG8_WAIT_L(0); PG8_BAR; PG8_MMA(0, 0, At, B0); PG8_MMA(0, 1, At, B1); PG8_BAR; PG8_SCHED;
            PG8_LDA(At, 0, 1); PG8_STAGE(PG8_SB(0, 0), b2, voffB); PG8_STAGE(PG8_SB(0, 1), b2 + hstepB, voffB); PG8_STAGE(PG8_SA(0, 0), a2, voffA);
            PG8_WAIT_V(8); PG8_WAIT_L(0); PG8_BAR; PG8_MMA(1, 0, At, B0); PG8_MMA(1, 1, At, B1); PG8_BAR; PG8_SCHED;
            PG8_LDB(B0, 1, 0); PG8_LDB(B1, 1, 1); PG8_SCHED; PG8_LDA(At, 1, 0); PG8_STAGE(PG8_SA(0, 1), a2 + hstepA, voffA);
            PG8_WAIT_V(8); PG8_WAIT_L(0); PG8_BAR; PG8_MMA(0, 0, At, B0); PG8_MMA(0, 1, At, B1); PG8_BAR; PG8_SCHED;
            PG8_LDA(At, 1, 1); PG8_STAGE(PG8_SB(1, 0), b3, voffB); PG8_STAGE(PG8_SB(1, 1), b3 + hstepB, voffB); PG8_STAGE(PG8_SA(1, 0), a3, voffA);
            PG8_WAIT_V(8); PG8_WAIT_L(0); PG8_BAR; PG8_MMA(1, 0, At, B0); PG8_MMA(1, 1, At, B1); PG8_BAR; PG8_SCHED;
        }
        STAMP(pf, PB);
        if constexpr (ALIGN_EPI) { if (wr == 0) PG8_BAR; }
        STAMP(pf, PB + 2);
        E(acc, cur, wr, wc, fr, fq);
        STAMP(pf, PB + 1);
#ifdef EPI_TWICE
        asm volatile("" ::: "memory"); E(acc, cur, wr, wc, fr, fq);
#endif
        if (!has_next) break;
#pragma unroll
        for (int a = 0; a < 2; ++a)
#pragma unroll
            for (int b = 0; b < 2; ++b)
#pragma unroll
                for (int m = 0; m < 4; ++m)
#pragma unroll
                    for (int n = 0; n < 2; ++n) acc[a][b][m][n] = (f32x4){0.f, 0.f, 0.f, 0.f};
        cur = nxt; cA = nA; cB = nB; ++ui;
        if constexpr (ALIGN_EPI) { if (wr == 1) PG8_BAR; }
    }
    PG8_WAIT_V(0);
    if constexpr (!ALIGN_EPI) { if (wr == 0) PG8_BAR; }
    PG8_BAR;
#undef PG8_SA
#undef PG8_SB
#undef PG8_STAGE
#undef PG8_LDA
#undef PG8_LDB
#undef PG8_MMA
#undef PG8_WAIT_V
#undef PG8_WAIT_L
#undef PG8_BAR
#undef PG8_SCHED
}
}

struct EpiP1 {
    static constexpr bool PERM = true, HAS_MID = false;
    bf16_t* QKV; bf16_t* GAB; bf16_t* Rb; bf16_t* G1b; const float *qna, *kna, *qnb, *knb, *bm;
    __device__ __forceinline__ void operator()(const f32x4 (&acc)[2][2][4][2], const pg8::Unit& u, int wr, int wc, int fr, int fq) const {
        const int row0 = u.pm * 256 + wr * 64 + fr;
        if (u.pn < 25) {
            const int hc0 = u.pn * 256 + wc * 64;
            const float* gain = nullptr; float sc = 1.f;
            if (hc0 < C_KA) { gain = qna; sc = QSCALE; } else if (hc0 < C_VA) { gain = kna; } else if (hc0 < C_QB) { } else if (hc0 < C_KB) { gain = qnb; sc = QSCALE; } else if (hc0 < C_VB) { gain = knb; }
            f32x4 gv[2][2];
#pragma unroll
            for (int bj = 0; bj < 2; ++bj)
#pragma unroll
                for (int n = 0; n < 2; ++n) gv[bj][n] = gain ? *(const f32x4*)(gain + 32 * bj + 8 * fq + 4 * n) * sc : (f32x4){1.f, 1.f, 1.f, 1.f};
            bf16_t* base; int ld;
            if (hc0 < C_GA) { base = QKV + hc0; ld = QKV_LD; } else { base = GAB + (hc0 - C_GA); ld = 1024; }
#pragma unroll
            for (int ai = 0; ai < 2; ++ai)
#pragma unroll
                for (int m = 0; m < 4; ++m) {
                    float rstd = 1.f;
                    if (gain) {
                        float ss = 0.f;
#pragma unroll
                        for (int bj = 0; bj < 2; ++bj)
#pragma unroll
                            for (int n = 0; n < 2; ++n) { const f32x4 x = acc[ai][bj][m][n]; ss += (x[0] * x[0] + x[1] * x[1]) + (x[2] * x[2] + x[3] * x[3]); }
                        ss += __shfl_xor(ss, 16); ss += __shfl_xor(ss, 32);
                        rstd = rsqrtf(ss * (1.f / 64.f) + EPS);
                    }
                    bf16_t* rowp = base + (size_t)(row0 + ai * 128 + m * 16) * ld + 8 * fq;
#pragma unroll
                    for (int bj = 0; bj < 2; ++bj) { const f32x4 v0 = acc[ai][bj][m][0] * gv[bj][0] * rstd, v1 = acc[ai][bj][m][1] * gv[bj][1] * rstd;
                        u32x4 w; w.x = cvtpk(v0[0], v0[1]); w.y = cvtpk(v0[2], v0[3]); w.z = cvtpk(v1[0], v1[1]); w.w = cvtpk(v1[2], v1[3]);
                        *(u32x4*)(rowp + 32 * bj) = w; }
                }
        } else {
            const int c0 = 128 * (u.pn - 25) + wc * 32 + 8 * fq;
            f32x4 b0[2], b1[2];
#pragma unroll
            for (int n = 0; n < 2; ++n) { b0[n] = *(const f32x4*)(bm + c0 + 4 * n); b1[n] = *(const f32x4*)(bm + 1024 + c0 + 4 * n); }
#pragma unroll
            for (int ai = 0; ai < 2; ++ai)
#pragma unroll
                for (int m = 0; m < 4; ++m) {
                    const size_t off = (size_t)(row0 + ai * 128 + m * 16) * 1024 + c0;
                    float r[8], g[8];
#pragma unroll
                    for (int n = 0; n < 2; ++n)
#pragma unroll
                        for (int j = 0; j < 4; ++j) { const float z0 = acc[ai][0][m][n][j] + b0[n][j], z1 = acc[ai][1][m][n][j] + b1[n][j];
                            const float e0 = 1.f + __expf(-z0), e1 = 1.f + __expf(-z1); const float g1 = __builtin_amdgcn_rcpf(e1);
                            g[4 * n + j] = g1; r[4 * n + j] = e1 * __builtin_amdgcn_rcpf(e0); }
                    u32x4 w; w.x = cvtpk(r[0], r[1]); w.y = cvtpk(r[2], r[3]); w.z = cvtpk(r[4], r[5]); w.w = cvtpk(r[6], r[7]); *(u32x4*)(Rb + off) = w;
                    w.x = cvtpk(g[0], g[1]); w.y = cvtpk(g[2], g[3]); w.z = cvtpk(g[4], g[5]); w.w = cvtpk(g[6], g[7]); *(u32x4*)(G1b + off) = w;
                }
        }
    }
};
struct EpiP4 {
    static constexpr bool PERM = true, HAS_MID = true;
    const bf16_t* Rb; const bf16_t* G1b; bf16_t* MER;
    __device__ __forceinline__ void mid(f32x4 (&acc)[2][2][4][2], const pg8::Unit& u, int wr, int wc, int fr, int fq) const {
        const int row0 = u.pm * 256 + wr * 64 + fr, col0 = u.pn * 256 + wc * 32 + 8 * fq;
        const bf16_t* rb = Rb + (size_t)row0 * 1024 + col0; asm volatile("" : "+v"(rb));
#pragma unroll
        for (int ai = 0; ai < 2; ++ai)
#pragma unroll
            for (int m = 0; m < 4; ++m)
#pragma unroll
                for (int bj = 0; bj < 2; ++bj) { const u32x4 w = *(const __attribute__((address_space(1))) u32x4*)(rb + (size_t)(ai * 128 + m * 16) * 1024 + bj * 128);
                    acc[ai][bj][m][0] *= (f32x4){bflo(w.x), bfhi(w.x), bflo(w.y), bfhi(w.y)}; acc[ai][bj][m][1] *= (f32x4){bflo(w.z), bfhi(w.z), bflo(w.w), bfhi(w.w)};
                    if (bj == 1 && (m & 1)) asm volatile("" ::: "memory"); }
    }
    __device__ __forceinline__ void operator()(const f32x4 (&acc)[2][2][4][2], const pg8::Unit& u, int wr, int wc, int fr, int fq) const {
        const int row0 = u.pm * 256 + wr * 64 + fr, col0 = u.pn * 256 + wc * 32 + 8 * fq;
#pragma unroll
        for (int ai = 0; ai < 2; ++ai)
#pragma unroll
            for (int m = 0; m < 4; ++m)
#pragma unroll
                for (int bj = 0; bj < 2; ++bj) { const size_t off = (size_t)(row0 + ai * 128 + m * 16) * 1024 + col0 + bj * 128; const u32x4 w = *(const u32x4*)(G1b + off);
                    const f32x4 v0 = acc[ai][bj][m][0] * (f32x4){bflo(w.x), bfhi(w.x), bflo(w.y), bfhi(w.y)}, v1 = acc[ai][bj][m][1] * (f32x4){bflo(w.z), bfhi(w.z), bflo(w.w), bfhi(w.w)};
                    u32x4 o; o.x = cvtpk(v0[0], v0[1]); o.y = cvtpk(v0[2], v0[3]); o.z = cvtpk(v1[0], v1[1]); o.w = cvtpk(v1[2], v1[3]); *(u32x4*)(MER + off) = o;
                    if (bj == 1 && (m & 1)) asm volatile("" ::: "memory"); }
    }
};
struct EpiP5 {
    static constexpr bool PERM = false, HAS_MID = false;
    const float* x; float* out;
    __device__ __forceinline__ void operator()(const f32x4 (&acc)[2][2][4][2], const pg8::Unit& u, int wr, int wc, int fr, int fq) const {
        const int row0 = u.pm * 256 + wr * 64 + fr, col0 = u.pn * 256 + wc * 32 + 4 * fq;
#pragma unroll
        for (int ai = 0; ai < 2; ++ai)
#pragma unroll
            for (int m = 0; m < 4; ++m) {
#pragma unroll
                for (int bj = 0; bj < 2; ++bj)
#pragma unroll
                    for (int n = 0; n < 2; ++n) { const size_t off = (size_t)(row0 + ai * 128 + m * 16) * 1024 + col0 + bj * 128 + n * 16; *(f32x4*)(out + off) = *(const f32x4*)(x + off) + acc[ai][bj][m][n]; }
                if (m & 1) asm volatile("" ::: "memory");
            }
    }
};

constexpr int RING_BYTES = 131072, TAB_OFF = RING_BYTES, WSF_OFF = TAB_OFF + 6144, LDS_BYTES = WSF_OFF + 2048 + 1024;

__device__ __forceinline__ void p0_transpose_item(const float* W, int N, bf16_t* WT, int ldt, int koff, int drow0, LAS float* scr, int k0, int n0, int lane) {
#pragma unroll 8
    for (int i = 0; i < 32; ++i) { const int kk = 2 * i + (lane >> 5); scr[kk * 33 + (lane & 31)] = W[(size_t)(k0 + kk) * N + n0 + (lane & 31)]; }
    asm volatile("s_waitcnt lgkmcnt(0)" ::: "memory");
    const int c = lane & 7;
#pragma unroll
    for (int j = 0; j < 4; ++j) { const int n = (lane >> 3) + 8 * j; const LAS float* s = scr + (8 * c) * 33 + n;
        u32x4 o; o.x = pk2(s[0 * 33], s[1 * 33]); o.y = pk2(s[2 * 33], s[3 * 33]); o.z = pk2(s[4 * 33], s[5 * 33]); o.w = pk2(s[6 * 33], s[7 * 33]);
        *(u32x4*)(WT + (size_t)(drow0 + n) * ldt + koff + k0 + 8 * c) = o; }
    asm volatile("s_waitcnt lgkmcnt(0)" ::: "memory");
}
__device__ __forceinline__ int win_dest_row(int n0) {
    if (n0 < C_MG) { const int pn = n0 >> 8, rem = n0 & 255; return 256 * pn + 128 * ((rem >> 5) & 1) + 32 * (rem >> 6); }
    const int mc = n0 - C_MG, bj = mc >> 10, c = mc & 1023; return 256 * (25 + (c >> 7)) + 128 * bj + 32 * ((c & 127) >> 5);
}
struct Ptrs {
    const float *x, *gain, *Win, *qna, *kna, *qnb, *knb, *sink, *relb, *Wa, *Wb, *bm, *Wout; float* out;
    bf16_t *WinT, *WabT, *WoutT, *XN, *MER, *GAB, *QKV, *Rb, *G1b; float *LSE, *TABG, *CH;
};
__device__ __forceinline__ void p0_prologue(LAS unsigned char* lds, const Ptrs& P, int vcu, int G, int wave, int lane) {
    LAS float* scr = (LAS float*)(lds + wave * 16384);
    const int gw = vcu * 8 + wave, NGW = G * 8;
    constexpr int I_IN = 16 * (NIN / 32), I_A = 8 * 32, I_B = 8 * 32, I_O = 16 * 32, NITEMS = I_IN + I_A + I_B + I_O;
    for (int it = gw; it < NITEMS; it += NGW) {
        int r = it;
        if (r < I_IN) { const int kb = r / (NIN / 32), nb = r % (NIN / 32); p0_transpose_item(P.Win, NIN, P.WinT, 1024, 0, win_dest_row(32 * nb), scr, 64 * kb, 32 * nb, lane); continue; } r -= I_IN;
        if (r < I_A) { const int kb = r >> 5, nb = r & 31; p0_transpose_item(P.Wa, 1024, P.WabT, 1024, 0, 32 * nb, scr, 64 * kb, 32 * nb, lane); continue; } r -= I_A;
        if (r < I_B) { const int kb = r >> 5, nb = r & 31; p0_transpose_item(P.Wb, 1024, P.WabT, 1024, 512, 32 * nb, scr, 64 * kb, 32 * nb, lane); continue; } r -= I_B;
        { const int kb = r >> 5, nb = r & 31; p0_transpose_item(P.Wout, 1024, P.WoutT, 1024, 0, 32 * nb, scr, 64 * kb, 32 * nb, lane); }
    }
    if (wave == 0 && vcu < 32) {
        const int ht = vcu, isA = ht < 8, g = isA ? 0 : (ht - 8) >> 3, dsh = 2 * g, HW = isA ? 128 : 64;
        const float* gq = isA ? P.qna : P.qnb; const float* gk = isA ? P.kna : P.knb;
        float a = fabsf(gq[lane]), b = fabsf(gk[lane]), c = lane < 32 ? fabsf(P.relb[lane * 32 + ht]) : 0.f;
#pragma unroll
        for (int sft = 1; sft < 64; sft <<= 1) { a = fmaxf(a, __shfl_xor(a, sft)); b = fmaxf(b, __shfl_xor(b, sft)); c = fmaxf(c, __shfl_xor(c, sft)); }
        const float C = 64.f * QSCALE * a * b * 1.02f + c * LOG2E + 0.5f;
        if (lane == 0) P.CH[ht] = C;
        for (int e = lane; e < 384; e += 64) { const int rel = e - 191, arel = rel < 0 ? -rel : rel;
            P.TABG[ht * 384 + e] = (arel <= HW) ? P.relb[t5_bucket(rel << dsh) * 32 + ht] * LOG2E - C : -1e30f; }
    }
    for (int row = gw; row < MTOK; row += 2 * NGW) {
        const int row2 = row + NGW;
        const bool has2 = row2 < MTOK;
        const float4* xr = (const float4*)(P.x + (size_t)row * DM) + lane; const float4* xr2 = (const float4*)(P.x + (size_t)(has2 ? row2 : row) * DM) + lane;
        float4 v[4], u[4]; float s = 0.f, s2 = 0.f;
#pragma unroll
        for (int j = 0; j < 4; ++j) { v[j] = xr[64 * j]; u[j] = xr2[64 * j]; }
#pragma unroll
        for (int j = 0; j < 4; ++j) { s += (v[j].x * v[j].x + v[j].y * v[j].y) + (v[j].z * v[j].z + v[j].w * v[j].w); s2 += (u[j].x * u[j].x + u[j].y * u[j].y) + (u[j].z * u[j].z + u[j].w * u[j].w); }
#pragma unroll
        for (int o = 1; o < 64; o <<= 1) { s += __shfl_xor(s, o); s2 += __shfl_xor(s2, o); }
        const float rstd = rsqrtf(s * (1.f / DM) + EPS), rstd2 = rsqrtf(s2 * (1.f / DM) + EPS);
        uint2* o8 = (uint2*)(P.XN + (size_t)row * DM) + lane; uint2* o82 = (uint2*)(P.XN + (size_t)row2 * DM) + lane;
#pragma unroll
        for (int j = 0; j < 4; ++j) { const float4 g = ((const float4*)P.gain)[lane + 64 * j];
            uint2 w; w.x = cvtpk(v[j].x * rstd * g.x, v[j].y * rstd * g.y); w.y = cvtpk(v[j].z * rstd * g.z, v[j].w * rstd * g.w); o8[64 * j] = w;
            if (has2) { uint2 w2; w2.x = cvtpk(u[j].x * rstd2 * g.x, u[j].y * rstd2 * g.y); w2.y = cvtpk(u[j].z * rstd2 * g.z, u[j].w * rstd2 * g.w); o82[64 * j] = w2; } }
    }
}

namespace att {
__device__ __forceinline__ void glds16(const void* gsrc, unsigned lds_dst) { unsigned keep;
    asm volatile("s_mov_b32 %0, m0\n\ts_mov_b32 m0, %2\n\ts_nop 0\n\tglobal_load_lds_dwordx4 %1, off\n\ts_mov_b32 m0, %0" : "=&s"(keep) : "v"(gsrc), "s"(lds_dst) : "memory"); }
struct UnitP { int prob, dsh, b, c, ub  , qcol0, kcol0, vcol0, bh0, key, seq, uidx  , jlo, jhi, nj; };
__device__ __forceinline__ UnitP decode(int ui, int vcu) {
    UnitP U;
    if (ui < 4) { const int j = 4 * vcu + ui; U.prob = 0; U.dsh = 0; U.uidx = j & 63; const int kvh = (j >> 6) & 1; U.b = j >> 7; U.c = 0; U.ub = 64 * U.uidx;
        U.qcol0 = C_QA + 4 * kvh * 64; U.kcol0 = C_KA + kvh * 64; U.vcol0 = C_VA + kvh * 64; U.bh0 = 4 * kvh; U.key = kvh; U.seq = j >> 6; U.nj = 64;
        U.jlo = U.uidx - 2 > 0 ? U.uidx - 2 : 0; U.jhi = U.uidx + 2 < 63 ? U.uidx + 2 : 63; }
    else { const int jb = 12 * vcu + (ui - 4), g = jb >> 10, j = jb & 1023; U.prob = 1 + g; U.dsh = 2 * g; const int nus = 5 - U.dsh; U.uidx = j & ((1 << nus) - 1); int rest = j >> nus; const int hp = rest & 3; rest >>= 2; U.c = rest & ((1 << U.dsh) - 1); U.b = rest >> U.dsh;
        U.ub = 128 * U.uidx; U.qcol0 = C_QB + g * 512 + 2 * hp * 64; U.kcol0 = C_KB + g * 512 + 2 * hp * 64; U.vcol0 = C_VB + g * 512 + 2 * hp * 64; U.bh0 = 8 + 8 * g + 2 * hp; U.key = 2 + 4 * g + hp; U.seq = 1024 + (jb >> nus); U.nj = SEQ >> (U.dsh + 6);
        U.jlo = 2 * U.uidx - 1 > 0 ? 2 * U.uidx - 1 : 0; U.jhi = 2 * U.uidx + 2 < U.nj - 1 ? 2 * U.uidx + 2 : U.nj - 1; }
    return U;
}
__device__ __forceinline__ void dma_tile(const bf16_t* QKV, const UnitP& U, int j, unsigned sb, int wid, int lane) {
    const size_t rowb = (size_t)U.b * SEQ; const int nslot = U.prob == 0 ? 1 : 2;
    const int row = 8 * wid + (lane >> 3), cp = lane & 7;
    const bf16_t* rp = QKV + (rowb + (size_t)((64 * j + row) << U.dsh) + U.c) * QKV_LD;
    const bf16_t* ks = rp + U.kcol0 + ((cp ^ (lane >> 3)) << 3);
    const bf16_t* vs = rp + U.vcol0 + (((((cp >> 2) ^ (lane >> 4)) & 1) << 2 | (cp & 3)) << 3);
    for (int s = 0; s < nslot; ++s) {
        glds16(ks + s * 64, (unsigned)__builtin_amdgcn_readfirstlane(sb + s * 16384 + wid * 1024));
        glds16(vs + s * 64, (unsigned)__builtin_amdgcn_readfirstlane(sb + s * 16384 + 8192 + wid * 1024));
    }
}
__device__ __forceinline__ void att_step(const bool FAST, f32x16 (&o)[2], f32x16& ol, float& mrun, const bf16x8 (&qr)[4], const LAS float* tb, const LAS unsigned char* kb, int vbb, int hi, int r32, int lane, bf16x8 ones) {
    f32x16 p0, p1;
#pragma unroll
    for (int r = 0; r < 16; ++r) { p0[r] = tb[(r & 3) + 8 * (r >> 2)]; p1[r] = tb[32 + (r & 3) + 8 * (r >> 2)]; }
#pragma unroll
    for (int d0 = 0; d0 < 4; ++d0) { const int ko = ((2 * d0 + hi) ^ (r32 & 7)) << 4; const bf16x8 k0 = *(const LAS bf16x8*)(kb + ko), k1 = *(const LAS bf16x8*)(kb + ko + 4096);
        p0 = __builtin_amdgcn_mfma_f32_32x32x16_bf16(k0, qr[d0], p0, 0, 0, 0); p1 = __builtin_amdgcn_mfma_f32_32x32x16_bf16(k1, qr[d0], p1, 0, 0, 0); }
    if (!FAST) {
        float rm = fmaxf(p0[0], p1[0]);
#pragma unroll
        for (int r = 1; r < 16; ++r) rm = fmaxf(rm, fmaxf(p0[r], p1[r]));
        { auto rr = __builtin_amdgcn_permlane32_swap(__float_as_uint(rm), __float_as_uint(rm), false, false); rm = fmaxf(__uint_as_float(rr[0]), __uint_as_float(rr[1])); }
        const float mn = fmaxf(mrun, rm), alpha = __builtin_amdgcn_exp2f(mrun - mn); mrun = mn;
        o[0] *= alpha; o[1] *= alpha; ol *= alpha;
#pragma unroll
        for (int r = 0; r < 16; ++r) { p0[r] -= mn; p1[r] -= mn; }
    }
#pragma unroll
    for (int r = 0; r < 16; ++r) { p0[r] = __builtin_amdgcn_exp2f(p0[r]); p1[r] = __builtin_amdgcn_exp2f(p1[r]); }
    u32x4 pw[4];
    pw[0] = (u32x4){cvtpk(p0[0], p0[1]), cvtpk(p0[2], p0[3]), cvtpk(p0[4], p0[5]), cvtpk(p0[6], p0[7])};
    pw[1] = (u32x4){cvtpk(p0[8], p0[9]), cvtpk(p0[10], p0[11]), cvtpk(p0[12], p0[13]), cvtpk(p0[14], p0[15])};
    pw[2] = (u32x4){cvtpk(p1[0], p1[1]), cvtpk(p1[2], p1[3]), cvtpk(p1[4], p1[5]), cvtpk(p1[6], p1[7])};
    pw[3] = (u32x4){cvtpk(p1[8], p1[9]), cvtpk(p1[10], p1[11]), cvtpk(p1[12], p1[13]), cvtpk(p1[14], p1[15])};
    const int vq = (lane & 15) >> 2, vb0 = vbb + ((vq >> 1) & 1) * 64, vb1 = vbb + (((vq >> 1) & 1) ^ 1) * 64;
#pragma unroll
    for (int d0 = 0; d0 < 2; ++d0) { s16x4 lo[4], hh[4]; const int vb = d0 ? vb1 : vb0;
#pragma unroll
        for (int ks = 0; ks < 4; ++ks) {
            asm volatile("ds_read_b64_tr_b16 %0,%1 offset:%c2" : "=&v"(lo[ks]) : "v"(vb), "i"(ks * 2048) : "memory");
            asm volatile("ds_read_b64_tr_b16 %0,%1 offset:%c2" : "=&v"(hh[ks]) : "v"(vb), "i"(ks * 2048 + 1024) : "memory"); }
        if (d0 == 0) {
#pragma unroll
            for (int ks = 0; ks < 4; ++ks) ol = __builtin_amdgcn_mfma_f32_32x32x16_bf16(ones, __builtin_bit_cast(bf16x8, pw[ks]), ol, 0, 0, 0);
        }
        asm volatile("s_waitcnt lgkmcnt(0)" ::: "memory"); __builtin_amdgcn_sched_barrier(0);
#pragma unroll
        for (int ks = 0; ks < 4; ++ks) { const bf16x8 vf = (bf16x8){lo[ks][0], lo[ks][1], lo[ks][2], lo[ks][3], hh[ks][0], hh[ks][1], hh[ks][2], hh[ks][3]};
            o[d0] = __builtin_amdgcn_mfma_f32_32x32x16_bf16(vf, __builtin_bit_cast(bf16x8, pw[ks]), o[d0], 0, 0, 0); }
    }
}
#define ATT_WAIT_BAR() do { asm volatile("s_waitcnt vmcnt(0) lgkmcnt(0)" ::: "memory"); __builtin_amdgcn_s_barrier(); } while (0)
#define ATT_BAR() do { asm volatile("s_waitcnt lgkmcnt(0)" ::: "memory"); __builtin_amdgcn_s_barrier(); } while (0)
__device__ __forceinline__ void attn_phase(LAS unsigned char* lds, const Ptrs& P, int vcu, int dry, Prof& pf) {
    const int tid = threadIdx.x, lane = tid & 63, r32 = lane & 31, hi = lane >> 5;
    const int wid = __builtin_amdgcn_readfirstlane(tid >> 6);
    const unsigned lds0 = (unsigned)(uintptr_t)lds;
    LAS float* tabs = (LAS float*)(lds + TAB_OFF);
    bf16_t* QKV = P.QKV;
    const short one = (r32 == 0) ? (short)0x3F80 : (short)0; const bf16x8 ones = (bf16x8){one, one, one, one, one, one, one, one};
    int tab_key = -1, prev_seq = -1, prev_u = -100; float Ch = 0.f; bool fast = true;
    UnitP U = decode(0, vcu);
#define WAVE_ROLE(UU, hs_, qoff_) const int hs_ = (UU).prob == 0 ? (wid >> 1) : ((wid >> 1) & 1); const int qoff_ = (UU).prob == 0 ? 32 * (wid & 1) : 32 * (2 * (wid >> 2) + (wid & 1))
    bf16x8 qn[4];
    { WAVE_ROLE(U, hs0, qo0); const bf16_t* Qn = QKV + ((size_t)U.b * SEQ + (size_t)((U.ub + qo0 + r32) << U.dsh) + U.c) * QKV_LD + U.qcol0 + hs0 * 64;
#pragma unroll
      for (int d0 = 0; d0 < 4; ++d0) qn[d0] = *(const bf16x8*)(Qn + d0 * 16 + hi * 8); }
    for (int ui = 0; ui < 16; ++ui) {
        const UnitP N = decode(ui + 1 < 16 ? ui + 1 : ui, vcu);
        const int dsh = U.dsh, prob = U.prob;
        const bool fresh = !(U.seq == prev_seq && U.uidx == prev_u + 1);
        const bool ncont = (ui + 1 < 16) && N.seq == U.seq && N.uidx == U.uidx + 1;
        WAVE_ROLE(U, hs, qoff);
        const LAS float* tab = tabs + hs * 384;
        STAMP(pf, 5);
        if (fresh) ATT_BAR();
        if (U.key != tab_key) {
            const int nt = (prob == 0 ? 4 : 2) * 384;
            for (int e = tid; e < nt; e += 512) tabs[e] = P.TABG[U.bh0 * 384 + e];
            tab_key = U.key; Ch = P.CH[U.bh0 + hs]; fast = Ch <= 60.f;
        }
        STAMP(pf, 0);
        const size_t rowb = (size_t)U.b * SEQ;
        const int mqb = U.ub + qoff, qcol = U.qcol0 + hs * 64;
        bf16_t* Qrow = QKV + (rowb + (size_t)((mqb + r32) << dsh) + U.c) * QKV_LD + qcol;
        bf16x8 qr[4];
#pragma unroll
        for (int d0 = 0; d0 < 4; ++d0) { qr[d0] = qn[d0]; asm volatile("" : "+v"(qr[d0])); }
        STAMP(pf, 2);
        float mrun = -1e30f; f32x16 o[2], ol; o[0] = f32x16{}; o[1] = f32x16{}; ol = f32x16{};
        const int jbase = (U.uidx & ~3) - 2;
        if (fresh) {
            if (dry != 2) { if (prob == 0) { const int ja = jbase > 0 ? jbase : 0, jz = (jbase + 7) < 63 ? (jbase + 7) : 63; for (int j = ja; j <= jz; ++j) dma_tile(QKV, U, j, lds0 + (unsigned)(j - jbase) * 16384u, wid, lane); }
                            else for (int j = U.jlo; j <= U.jhi; ++j) dma_tile(QKV, U, j, lds0 + (unsigned)(j & 3) * 32768u, wid, lane); }
            ATT_WAIT_BAR();
        }
        if (prob == 0 && ui + 1 < 16) { WAVE_ROLE(N, hsn, qon); const bf16_t* Qn = QKV + ((size_t)N.b * SEQ + (size_t)((N.ub + qon + r32) << N.dsh) + N.c) * QKV_LD + N.qcol0 + hsn * 64;
#pragma unroll
            for (int d0 = 0; d0 < 4; ++d0) qn[d0] = *(const bf16x8*)(Qn + d0 * 16 + hi * 8); }
        STAMP(pf, 1);
        const int jwl = prob == 0 ? U.jlo : 2 * U.uidx - 1 + (wid >> 2), jwh = prob == 0 ? U.jhi : 2 * U.uidx + 1 + (wid >> 2);
        for (int j = U.jlo; j <= U.jhi; ++j) {
            if (prob != 0) {
                const int p = j - (2 * U.uidx - 1);
                if (p == 1) { ATT_WAIT_BAR();
                    if (ncont && 2 * U.uidx + 3 <= U.nj - 1 && dry != 2) dma_tile(QKV, U, 2 * U.uidx + 3, lds0 + (unsigned)((2 * U.uidx + 3) & 3) * 32768u, wid, lane);
                    if (ui + 1 < 16) { WAVE_ROLE(N, hsn, qon); const bf16_t* Qn = QKV + ((size_t)N.b * SEQ + (size_t)((N.ub + qon + r32) << N.dsh) + N.c) * QKV_LD + N.qcol0 + hsn * 64;
#pragma unroll
                        for (int d0 = 0; d0 < 4; ++d0) qn[d0] = *(const bf16x8*)(Qn + d0 * 16 + hi * 8); } }
                else if (p == 2) { ATT_BAR();
                    if (ncont && 2 * U.uidx + 4 <= U.nj - 1 && dry != 2) dma_tile(QKV, U, 2 * U.uidx + 4, lds0 + (unsigned)((2 * U.uidx + 4) & 3) * 32768u, wid, lane); }
            }
            STAMP(pf, 4);
            if (dry == 3 || j < jwl || j > jwh) continue;
            const unsigned sbase = prob == 0 ? (unsigned)(j - jbase) * 16384u : (unsigned)(j & 3) * 32768u + (unsigned)hs * 16384u;
            const LAS float* tb = tab + (191 + 64 * j - mqb + 4 * hi - r32);
            const LAS unsigned char* kb = lds + sbase + r32 * 128;
            const int vbb = (int)(lds0 + sbase + 8192) + (4 * hi + ((lane & 15) >> 2)) * 128 + ((lane >> 4) & 1) * 32 + (lane & 3) * 8;
            att_step(fast, o, ol, mrun, qr, tb, kb, vbb, hi, r32, lane, ones);
            STAMP(pf, 3);
        }
        float lrun = ol[0];
        { auto rr = __builtin_amdgcn_permlane32_swap(__float_as_uint(lrun), __float_as_uint(lrun), false, false); lrun = __uint_as_float(rr[0]) + __uint_as_float(rr[1]); }
        if (fast) mrun = 0.f;
        float inv;
        const size_t grow = rowb + (size_t)((mqb + r32) << dsh) + U.c;
        if (prob == 0) { const float sk = P.sink[U.bh0 + hs] * LOG2E - Ch, mn = fmaxf(mrun, sk), a = __builtin_amdgcn_exp2f(mrun - mn); inv = a * __builtin_amdgcn_rcpf(lrun * a + __builtin_amdgcn_exp2f(sk - mn)); }
        else { inv = __builtin_amdgcn_rcpf(lrun); if (hi == 0 && !dry) P.LSE[(size_t)(prob - 1) * MTOK * 8 + grow * 8 + (U.bh0 - 8 * prob) + hs] = Ch + mrun + __log2f(lrun); }
#pragma unroll
        for (int d0 = 0; d0 < 2; ++d0)
#pragma unroll
            for (int gp = 0; gp < 2; ++gp) {
                float v[8];
#pragma unroll
                for (int e = 0; e < 8; ++e) v[e] = o[d0][8 * gp + e] * inv;
                if (prob == 0) {
                    const bf16_t* gp0 = P.GAB + grow * 1024 + (U.bh0 + hs) * 64 + 32 * d0 + 16 * gp + 4 * hi;
                    const uint2 ga = *(const uint2*)gp0, gb = *(const uint2*)(gp0 + 8); const unsigned gw[4] = {ga.x, ga.y, gb.x, gb.y};
#pragma unroll
                    for (int e = 0; e < 4; ++e) { const float g0 = bflo(gw[e]), g1 = bfhi(gw[e]); v[2 * e] *= g0 * __builtin_amdgcn_rcpf(1.f + __expf(-g0)); v[2 * e + 1] *= g1 * __builtin_amdgcn_rcpf(1.f + __expf(-g1)); }
                }
                unsigned ax = cvtpk(v[0], v[1]), ay = cvtpk(v[2], v[3]), bx = cvtpk(v[4], v[5]), by = cvtpk(v[6], v[7]);
                { auto r = __builtin_amdgcn_permlane32_swap(ax, bx, false, false); ax = r[0]; bx = r[1]; }
                { auto r = __builtin_amdgcn_permlane32_swap(ay, by, false, false); ay = r[0]; by = r[1]; }
                if (!dry) *(u32x4*)(Qrow + 32 * d0 + 16 * gp + 8 * hi) = (u32x4){ax, ay, bx, by};
            }
        prev_seq = U.seq; prev_u = U.uidx; U = N;
    }
    STAMP(pf, 5);
    ATT_WAIT_BAR();
    STAMP(pf, 6);
#undef WAVE_ROLE
}
#undef ATT_WAIT_BAR
#undef ATT_BAR
}

__device__ __forceinline__ void p3_combine(const Ptrs& P, int vcu, int G, int wave, int lane, int dry) {
    const int h = lane >> 3;
    for (int t = vcu * 8 + wave; t < MTOK; t += G * 8) {
        float ls[3], mx = -1e30f;
#pragma unroll
        for (int g = 0; g < 3; ++g) { ls[g] = P.LSE[(size_t)g * MTOK * 8 + (size_t)t * 8 + h]; mx = fmaxf(mx, ls[g]); }
        float al[3], sum = 0.f;
#pragma unroll
        for (int g = 0; g < 3; ++g) { al[g] = exp2f(ls[g] - mx); sum += al[g]; }
        const float inv = 1.f / sum;
        float r[8] = {0.f, 0.f, 0.f, 0.f, 0.f, 0.f, 0.f, 0.f};
#pragma unroll
        for (int g = 0; g < 3; ++g) { const u32x4 v = *(const u32x4*)(P.QKV + (size_t)t * QKV_LD + C_QB + g * 512 + lane * 8); const unsigned w[4] = {v.x, v.y, v.z, v.w}; const float a = al[g] * inv;
#pragma unroll
            for (int e = 0; e < 4; ++e) { r[2 * e] += a * bflo(w[e]); r[2 * e + 1] += a * bfhi(w[e]); } }
        { const u32x4 g = *(const u32x4*)(P.GAB + (size_t)t * 1024 + 512 + lane * 8); const unsigned gw[4] = {g.x, g.y, g.z, g.w};
#pragma unroll
          for (int e = 0; e < 4; ++e) { const float g0 = bflo(gw[e]), g1 = bfhi(gw[e]); r[2 * e] *= g0 / (1.f + __expf(-g0)); r[2 * e + 1] *= g1 / (1.f + __expf(-g1)); } }
        u32x4 w; w.x = cvtpk(r[0], r[1]); w.y = cvtpk(r[2], r[3]); w.z = cvtpk(r[4], r[5]); w.w = cvtpk(r[6], r[7]);
        if (!dry) *(u32x4*)(P.QKV + (size_t)t * QKV_LD + 512 + lane * 8) = w;
    }
}

__device__ __forceinline__ void skew_delay(unsigned ticks) {
    if (ticks) { const unsigned long long t0 = __builtin_amdgcn_s_memrealtime(); while (__builtin_amdgcn_s_memrealtime() - t0 < (unsigned long long)ticks) __builtin_amdgcn_s_sleep(8); }
}
#ifndef SKEW1
#define SKEW1 0
#endif
#ifndef USE_CG_SYNC
#define USE_CG_SYNC 0
#endif
#ifndef SKEWN
#define SKEWN 4
#endif
#ifndef SKEW45
#define SKEW45 0
#endif

#define XB_TMO      128
#define XB_XCNT(j)  (256  + 64 * (j))
#define XB_XSUB(j)  (1280 + 64 * (j))
#define XB_XGEN(j)  (2304 + 64 * (j))
#define XB_TOP      3328
#define XB_TOPGEN   3392
#define XCD_BAR_WORDS 3456
#define XB_SPIN_CAP (1u << 18)
__device__ __forceinline__ unsigned xb_ld(unsigned* p)              { return __hip_atomic_load(p, __ATOMIC_RELAXED, __HIP_MEMORY_SCOPE_AGENT); }
__device__ __forceinline__ unsigned xb_add(unsigned* p, unsigned v) { return __hip_atomic_fetch_add(p, v, __ATOMIC_RELAXED, __HIP_MEMORY_SCOPE_AGENT); }
__device__ __forceinline__ unsigned xb_xcc_id() { return (unsigned)__builtin_amdgcn_s_getreg((3 << 11) | 20) & 0xFu; }
#define XB_SPIN(cond, bar) do { unsigned _sp = 0; while (cond) { __builtin_amdgcn_s_sleep(1); \
    if ((++_sp & 255u) == 0u) { if (xb_ld(&(bar)[XB_TMO])) break; if (_sp > XB_SPIN_CAP) { atomicAdd(&(bar)[XB_TMO], 1u); break; } } } } while (0)
struct XcdBarrier { unsigned* bar; unsigned x; volatile LAS unsigned* st; };
__device__ __forceinline__ XcdBarrier xcd_barrier_post(unsigned* bar, volatile LAS unsigned* st) {
    XcdBarrier b; b.bar = bar; b.x = xb_xcc_id(); b.st = st;
    if (threadIdx.x == 0) (void)xb_add(&bar[XB_XCNT(b.x)], 1u);
    return b;
}
__device__ __forceinline__ void xcd_barrier_complete(unsigned* bar, unsigned x, unsigned& nloc, unsigned& nx) {
    const unsigned G = gridDim.x * gridDim.y * gridDim.z;
    unsigned sum, cnt, mine, sp = 0u;
    for (;;) {
        sum = 0u; cnt = 0u; mine = 0u;
#pragma unroll
        for (unsigned j = 0; j < 16; ++j) { const unsigned c = xb_ld(&bar[XB_XCNT(j)]); sum += c; cnt += (c > 0u) ? 1u : 0u; mine = (j == x) ? c : mine; }
        if (sum == G) break;
        __builtin_amdgcn_s_sleep(1);
        if ((++sp & 255u) == 0u) { if (xb_ld(&bar[XB_TMO])) break; if (sp > XB_SPIN_CAP) { atomicAdd(&bar[XB_TMO], 1u); break; } }
    }
    nloc = mine > 0u ? mine : 1u; nx = cnt > 0u ? cnt : 1u;
}
__device__ __forceinline__ void xcd_barrier(const XcdBarrier& b) {
    asm volatile("s_waitcnt vmcnt(0)" ::: "memory");
    __syncthreads();
    if (threadIdx.x == 0) {
        unsigned* bar = b.bar;
        __builtin_amdgcn_s_waitcnt(0);
        unsigned nloc = b.st[0], nx = b.st[1];
        if (nloc == 0u) { xcd_barrier_complete(bar, b.x, nloc, nx); b.st[0] = nloc; b.st[1] = nx; }
        const unsigned old = xb_add(&bar[XB_XSUB(b.x)], 1u);
        const unsigned gen = old / nloc;
        if (old + 1u == (gen + 1u) * nloc) {
            __builtin_amdgcn_fence(__ATOMIC_RELEASE, "agent");
            asm volatile("s_waitcnt vmcnt(0)" ::: "memory");
            const unsigned og = xb_add(&bar[XB_TOP], 1u);
            const unsigned tg = og / nx;
            if (og + 1u == (tg + 1u) * nx) xb_add(&bar[XB_TOPGEN], 1u);
            else XB_SPIN(xb_ld(&bar[XB_TOPGEN]) == tg, bar);
            __builtin_amdgcn_fence(__ATOMIC_ACQUIRE, "agent");
            xb_add(&bar[XB_XGEN(b.x)], 1u);
            asm volatile("s_waitcnt vmcnt(0)" ::: "memory");
        } else {
            XB_SPIN(xb_ld(&bar[XB_XGEN(b.x)]) == gen, bar);
            __builtin_amdgcn_fence(__ATOMIC_ACQUIRE, "agent");
            asm volatile("s_waitcnt vmcnt(0)" ::: "memory");
        }
    }
    __syncthreads();
}
struct Args { const float* in[13]; float* out; unsigned char* ws; int ph_lo, ph_hi, dry, pad; };
__global__ void __launch_bounds__(512, 2) mega_fwd(Args a) {
    extern __shared__ __attribute__((aligned(16))) unsigned char lds_raw[];
    LAS unsigned char* lds = (LAS unsigned char*)lds_raw;
    cg::grid_group grid = cg::this_grid();
    const int tid = threadIdx.x, lane = tid & 63, wave = __builtin_amdgcn_readfirstlane(tid >> 6);
    const int G = gridDim.x, bx = blockIdx.x, vcu = (G % 8 == 0) ? (bx % 8) * (G / 8) + bx / 8 : bx;
    Ptrs P;
    P.x = a.in[0]; P.gain = a.in[1]; P.Win = a.in[2]; P.qna = a.in[3]; P.kna = a.in[4]; P.qnb = a.in[5]; P.knb = a.in[6]; P.sink = a.in[7]; P.relb = a.in[8];
    P.Wa = a.in[9]; P.Wb = a.in[10]; P.bm = a.in[11]; P.Wout = a.in[12]; P.out = a.out;
    unsigned char* ws = a.ws;
    P.WinT = (bf16_t*)(ws + WS_WIN); P.WabT = (bf16_t*)(ws + WS_WAB); P.WoutT = (bf16_t*)(ws + WS_WOUT); P.XN = (bf16_t*)(ws + WS_XN); P.MER = P.XN;
    P.GAB = (bf16_t*)(ws + WS_GAB); P.QKV = (bf16_t*)(ws + WS_QKV); P.LSE = (float*)(ws + WS_LSE); P.TABG = (float*)(ws + WS_CTL + 65536); P.CH = (float*)(ws + WS_CTL + 65536 + 32 * 384 * 4); P.Rb = (bf16_t*)a.out; P.G1b = P.Rb + (size_t)MTOK * 1024;
    const int lo = a.ph_lo, hi = a.ph_hi;
    { volatile LAS unsigned* stw = (volatile LAS unsigned*)(lds + WSF_OFF + 2048); if (tid < 2) stw[tid] = 0u; }
    __syncthreads();
    const XcdBarrier xbar = xcd_barrier_post((unsigned*)(a.ws + WS_CTL), (volatile LAS unsigned*)(lds + WSF_OFF + 2048));
    if (hi > 1000) grid.sync();
#if USE_CG_SYNC
#define GRID_BAR() grid.sync()
#else
#define GRID_BAR() xcd_barrier(xbar)
#endif
    Prof pf; pf.tl = 0;
#pragma unroll
    for (int k = 0; k < 32; ++k) pf.acc[k] = 0;
#if PROBE
    pf.tl = __builtin_amdgcn_s_memrealtime();
#endif
#ifndef PH_EN
#define PH_EN 0x3f
#endif
#define IN(k) (((PH_EN >> (k)) & 1) && lo <= (k) && (k) < hi)
#define BOTH(k) (IN(k) && IN((k) + 1))
#ifndef PH_REPEAT
#define PH_REPEAT 0
#endif
#ifndef DRY_MODE
#define DRY_MODE 1
#endif
#define NREP(k) (((PH_REPEAT >> (k)) & 1) ? 2 : 1)
    if (IN(0)) { p0_prologue(lds, P, vcu, G, wave, lane); STAMP(pf, 8); if (BOTH(0)) GRID_BAR(); STAMP(pf, 24); }
    if (IN(1)) {
        skew_delay((unsigned)(SKEW1) * (unsigned)((bx >> 3) & (SKEWN - 1)));
        pg8::Gemm g{P.XN, P.WinT, MTOK, NIN, 1024, 1024}; pg8::StaticOrder S; S.init(MTOK, NIN, G, bx);
        EpiP1 E{P.QKV, P.GAB, P.Rb, P.G1b, P.qna, P.kna, P.qnb, P.knb, P.bm};
        pg8::gemm_phase<EpiP1, true, 16>(lds, g, S, E, pf);
        STAMP(pf, 9);
        if (BOTH(1)) GRID_BAR();
        STAMP(pf, 25);
    }
    if (IN(2)) { att::attn_phase(lds, P, vcu, a.dry, pf); STAMP(pf, 10); if (BOTH(2)) GRID_BAR(); STAMP(pf, 26); }
    if (IN(3)) { p3_combine(P, vcu, G, wave, lane, a.dry); STAMP(pf, 11); if (BOTH(3)) GRID_BAR(); STAMP(pf, 27); }
    if (IN(4)) {
        skew_delay((unsigned)(SKEW45) * (unsigned)(bx & 7));
        pg8::Gemm g{P.QKV, P.WabT, MTOK, 1024, 1024, QKV_LD}; pg8::StaticOrder S; S.init(MTOK, 1024, G, bx);
        EpiP4 E{P.Rb, P.G1b, P.MER};
        pg8::gemm_phase<EpiP4, true, 20>(lds, g, S, E, pf);
        STAMP(pf, 12);
        if (BOTH(4)) GRID_BAR();
        STAMP(pf, 28);
    }
    if (IN(5)) {
        skew_delay((unsigned)(SKEW45) * (unsigned)(bx & 7));
        pg8::Gemm g{P.MER, P.WoutT, MTOK, 1024, 1024, 1024}; pg8::StaticOrder S; S.init(MTOK, 1024, G, bx);
        EpiP5 E{P.x, P.out};
        pg8::gemm_phase<EpiP5, true, 20>(lds, g, S, E, pf);
        STAMP(pf, 13);
    }
#if PROBE
    { unsigned tot = 0;
#pragma unroll
      for (int k = 0; k < 32; ++k) if ((PROBE_MASK >> k) & 1u) tot += pf.acc[k];
      skew_delay(tot); }
#endif
#undef IN
#undef BOTH
}


#ifndef MEGA_MASK
#define MEGA_MASK 0x3f
#endif
#ifndef ONE_LAUNCH
#define ONE_LAUNCH 1
#endif
extern "C" void kernel_launch(void* const* d_in, const int* in_sizes, int n_in, void* d_out, int out_size, void* d_ws, size_t ws_size, hipStream_t stream) {
    static int grid = 0;
    if (grid == 0) {
        if (n_in != 13 || out_size != MTOK * DM || ws_size < WS_END) { fprintf(stderr, "kernel_launch: unexpected shapes (n_in %d out %d ws %zu)\n", n_in, out_size, ws_size); grid = -1; return; }
        int dev = 0, cus = 0, per_cu = 0;
        if (hipGetDevice(&dev) != hipSuccess || hipDeviceGetAttribute(&cus, hipDeviceAttributeMultiprocessorCount, dev) != hipSuccess) { grid = -1; return; }
        if (hipFuncSetAttribute((const void*)mega_fwd, hipFuncAttributeMaxDynamicSharedMemorySize, LDS_BYTES) != hipSuccess) { fprintf(stderr, "kernel_launch: hipFuncSetAttribute failed\n"); grid = -1; return; }
        if (hipOccupancyMaxActiveBlocksPerMultiprocessor(&per_cu, (const void*)mega_fwd, 512, LDS_BYTES) != hipSuccess || per_cu < 1) { fprintf(stderr, "kernel_launch: occupancy query says %d blocks per CU\n", per_cu); (void)hipGetLastError(); grid = -1; return; }
        grid = cus;
    }
    if (grid < 0) return;
    Args a{};
    for (int i = 0; i < 13; ++i) a.in[i] = (const float*)d_in[i];
    a.out = (float*)d_out; a.ws = (unsigned char*)d_ws;
#if ONE_LAUNCH
    a.ph_lo = 0; a.ph_hi = 6;
    if (hipMemsetAsync((char*)d_ws + WS_CTL, 0, 16384, stream) != hipSuccess) { fprintf(stderr, "kernel_launch: memset of the barrier words failed\n"); return; }
    void* args[] = {&a};
    hipError_t e = hipLaunchCooperativeKernel((const void*)mega_fwd, dim3(grid), dim3(512), args, LDS_BYTES, stream);
    if (e != hipSuccess) fprintf(stderr, "cooperative launch failed: %s (grid %d)\n", hipGetErrorString(e), grid);
#else
    const float* x = a.in[0]; unsigned char* ws = a.ws;
    bf16_t* XN = (bf16_t*)(ws + WS_XN); bf16_t* MER = XN; bf16_t* GAB = (bf16_t*)(ws + WS_GAB); bf16_t* QKV = (bf16_t*)(ws + WS_QKV); float* LSE = (float*)(ws + WS_LSE);
    bf16_t* Rb = (bf16_t*)d_out; bf16_t* G1b = Rb + (size_t)MTOK * 1024;
    for (int ph = 0; ph < 6; ++ph) {
        if ((MEGA_MASK >> ph) & 1) { a.ph_lo = ph; a.ph_hi = ph + 1; for (int rep = 0; rep < NREP(ph); ++rep) { a.dry = (rep + 1 < NREP(ph)) ? DRY_MODE : 0; hipLaunchKernelGGL(mega_fwd, dim3(grid), dim3(512), LDS_BYTES, stream, a); } continue; }
        switch (ph) {
        case 0: p0_naive<<<MTOK / 4, 256, 0, stream>>>(x, a.in[1], XN); break;
        case 1: p1_naive<<<dim3(116, MTOK / 64), 256, 0, stream>>>(XN, a.in[2], a.in[3], a.in[4], a.in[5], a.in[6], a.in[11], QKV, GAB, Rb, G1b); break;
        case 2: attn_naive<0><<<dim3(MTOK / 256, 8), 256, 0, stream>>>(QKV, GAB, a.in[8], a.in[7], LSE); attn_naive<1><<<dim3(MTOK / 256, 8), 256, 0, stream>>>(QKV, GAB, a.in[8], a.in[7], LSE);
                attn_naive<2><<<dim3(MTOK / 256, 8), 256, 0, stream>>>(QKV, GAB, a.in[8], a.in[7], LSE); attn_naive<3><<<dim3(MTOK / 256, 8), 256, 0, stream>>>(QKV, GAB, a.in[8], a.in[7], LSE); break;
        case 3: p2c_combine<<<MTOK / 4, 256, 0, stream>>>(QKV, GAB, LSE); break;
        case 4: p3_naive<<<dim3(16, MTOK / 64), 256, 0, stream>>>(QKV, a.in[9], a.in[10], Rb, G1b, MER); break;
        case 5: p4_naive<<<dim3(16, MTOK / 64), 256, 0, stream>>>(MER, a.in[12], x, (float*)d_out); break;
        }
    }
#endif
}
```

```cpp
#define MEGA_MASK 0x3f
#define ONE_LAUNCH 1
#include <hip/hip_runtime.h>
#include <cstdint>
#include <cstdio>

typedef unsigned short bf16_t;
constexpr int BATCH = 8, SEQ = 4096, DM = 1024, MTOK = BATCH * SEQ;
constexpr int NIN = 8448;
constexpr int C_QA = 0, C_KA = 512, C_VA = 640, C_QB = 768, C_KB = 2304, C_VB = 3840, C_GA = 5376, C_GB = 5888, C_MG = 6400;
constexpr int QKV_LD = 5376;
constexpr float LOG2E = 1.4426950408889634f;
constexpr float QSCALE = 0.125f * LOG2E;
constexpr float EPS = 1e-6f;

constexpr size_t MiB = (size_t)1 << 20;
constexpr size_t WS_CTL = 0, WS_WIN = 1 * MiB, WS_WAB = 18 * MiB, WS_WOUT = 20 * MiB, WS_LSE = 22 * MiB, WS_XN = 26 * MiB, WS_GAB = 90 * MiB, WS_QKV = 154 * MiB, WS_END = 490 * MiB;

__device__ __forceinline__ unsigned f2bf(float f) { unsigned u = __builtin_bit_cast(unsigned, f); return (u + 0x7fffu + ((u >> 16) & 1u)) >> 16; }
__device__ __forceinline__ float bf2f(unsigned b) { return __builtin_bit_cast(float, b << 16); }
__device__ __forceinline__ unsigned pk2(float lo, float hi) { return f2bf(lo) | (f2bf(hi) << 16); }

__global__ __launch_bounds__(256) void p0_naive(const float* __restrict__ x, const float* __restrict__ gain, bf16_t* __restrict__ XN) {
    const int lane = threadIdx.x & 63, wave = threadIdx.x >> 6;
    const int row = blockIdx.x * 4 + wave;
    const float4* xr = (const float4*)(x + (size_t)row * DM) + lane;
    float4 v[4]; float s = 0.f;
#pragma unroll
    for (int j = 0; j < 4; ++j) { v[j] = xr[64 * j]; s += v[j].x * v[j].x + v[j].y * v[j].y + v[j].z * v[j].z + v[j].w * v[j].w; }
#pragma unroll
    for (int o = 1; o < 64; o <<= 1) s += __shfl_xor(s, o);
    const float rstd = rsqrtf(s * (1.f / DM) + EPS);
    uint2* o8 = (uint2*)(XN + (size_t)row * DM) + lane;
#pragma unroll
    for (int j = 0; j < 4; ++j) { const float4 g = ((const float4*)gain)[lane + 64 * j];
        uint2 w; w.x = pk2(v[j].x * rstd * g.x, v[j].y * rstd * g.y); w.y = pk2(v[j].z * rstd * g.z, v[j].w * rstd * g.w); o8[64 * j] = w; }
}

__device__ __forceinline__ void tile_gemm(float (&acc)[4][4], const bf16_t* A, int lda, const float* B, int ldb, int K, float* As, float* Bs) {
    const int tid = threadIdx.x, ty = tid >> 4, tx = tid & 15;
    for (int k0 = 0; k0 < K; k0 += 16) {
        { const int r = tid >> 2, kk = (tid & 3) * 4; const uint2 v = *(const uint2*)(A + (size_t)r * lda + k0 + kk);
          As[(kk + 0) * 68 + r] = bf2f(v.x & 0xffffu); As[(kk + 1) * 68 + r] = bf2f(v.x >> 16); As[(kk + 2) * 68 + r] = bf2f(v.y & 0xffffu); As[(kk + 3) * 68 + r] = bf2f(v.y >> 16); }
        { const int kk = tid >> 4, c = (tid & 15) * 4; *(float4*)&Bs[kk * 64 + c] = *(const float4*)(B + (size_t)(k0 + kk) * ldb + c); }
        __syncthreads();
#pragma unroll
        for (int kk = 0; kk < 16; ++kk) {
            const float4 a = *(const float4*)&As[kk * 68 + ty * 4]; const float4 b = *(const float4*)&Bs[kk * 64 + tx * 4];
            const float av[4] = {a.x, a.y, a.z, a.w}, bv[4] = {b.x, b.y, b.z, b.w};
#pragma unroll
            for (int i = 0; i < 4; ++i)
#pragma unroll
                for (int j = 0; j < 4; ++j) acc[i][j] += av[i] * bv[j];
        }
        __syncthreads();
    }
}

__global__ __launch_bounds__(256) void p1_naive(const bf16_t* __restrict__ XN, const float* __restrict__ Win, const float* qna, const float* kna, const float* qnb, const float* knb,
                                                const float* bmerge, bf16_t* QKV, bf16_t* GAB, bf16_t* Rb, bf16_t* G1b) {
    __shared__ float As[16 * 68], Bs[16 * 64];
    const int tn = blockIdx.x, row0 = blockIdx.y * 64, tid = threadIdx.x, ty = tid >> 4, tx = tid & 15;
    const bf16_t* A = XN + (size_t)row0 * DM;
    if (tn < 100) {
        const int col0 = tn * 64;
        float acc[4][4] = {};
        tile_gemm(acc, A, DM, Win + col0, NIN, DM, As, Bs);
        const float* gain = nullptr; float sc = 1.f;
        if (col0 < C_KA) { gain = qna; sc = QSCALE; } else if (col0 < C_VA) { gain = kna; } else if (col0 < C_QB) { } else if (col0 < C_KB) { gain = qnb; sc = QSCALE; } else if (col0 < C_VB) { gain = knb; }
#pragma unroll
        for (int i = 0; i < 4; ++i) {
            const int row = row0 + ty * 4 + i;
            float v[4] = {acc[i][0], acc[i][1], acc[i][2], acc[i][3]};
            if (gain) {
                float ss = v[0] * v[0] + v[1] * v[1] + v[2] * v[2] + v[3] * v[3];
                ss += __shfl_xor(ss, 1); ss += __shfl_xor(ss, 2); ss += __shfl_xor(ss, 4); ss += __shfl_xor(ss, 8);
                const float rstd = rsqrtf(ss * (1.f / 64.f) + EPS);
#pragma unroll
                for (int j = 0; j < 4; ++j) v[j] = v[j] * rstd * gain[tx * 4 + j] * sc;
            }
            uint2 w; w.x = pk2(v[0], v[1]); w.y = pk2(v[2], v[3]);
            if (col0 < C_GA) *(uint2*)(QKV + (size_t)row * QKV_LD + col0 + tx * 4) = w;
            else *(uint2*)(GAB + (size_t)row * 1024 + (col0 - C_GA) + tx * 4) = w;
        }
    } else {
        const int c0 = (tn - 100) * 64;
        float a0[4][4] = {}, a1[4][4] = {};
        tile_gemm(a0, A, DM, Win + C_MG + c0, NIN, DM, As, Bs);
        tile_gemm(a1, A, DM, Win + C_MG + 1024 + c0, NIN, DM, As, Bs);
#pragma unroll
        for (int i = 0; i < 4; ++i) {
            const int row = row0 + ty * 4 + i; float r[4], g[4];
#pragma unroll
            for (int j = 0; j < 4; ++j) { const int c = c0 + tx * 4 + j; const float g0 = 1.f / (1.f + __expf(-(a0[i][j] + bmerge[c]))), g1 = 1.f / (1.f + __expf(-(a1[i][j] + bmerge[1024 + c]))); r[j] = g0 / g1; g[j] = g1; }
            uint2 w; w.x = pk2(r[0], r[1]); w.y = pk2(r[2], r[3]); *(uint2*)(Rb + (size_t)row * 1024 + c0 + tx * 4) = w;
            w.x = pk2(g[0], g[1]); w.y = pk2(g[2], g[3]); *(uint2*)(G1b + (size_t)row * 1024 + c0 + tx * 4) = w;
        }
    }
}

__device__ __forceinline__ int t5_bucket(int rel) {
    const int n = rel < 0 ? -rel : rel; const int ret = rel > 0 ? 16 : 0;
    if (n < 8) return ret + n;
    int large = 8 + (int)(logf((float)n / 8.f) / 4.852030263919617f * 8.f);
    if (large > 15) large = 15;
    return ret + large;
}
template <int PROB>
__global__ __launch_bounds__(256) void attn_naive(bf16_t* QKV, const bf16_t* __restrict__ GAB, const float* __restrict__ rel_bias, const float* __restrict__ sink, float* LSE) {
    constexpr int dil = PROB == 0 ? 1 : (PROB == 1 ? 1 : (PROB == 2 ? 4 : 16));
    constexpr int HW = PROB == 0 ? 128 : 64;
    __shared__ float sb[2 * HW + 1];
    const int h = blockIdx.y, t = blockIdx.x * 256 + threadIdx.x, b = t / SEQ, s = t % SEQ;
    const int qcol = PROB == 0 ? C_QA + h * 64 : C_QB + (PROB - 1) * 512 + h * 64;
    const int kcol = PROB == 0 ? C_KA + (h >> 2) * 64 : C_KB + (PROB - 1) * 512 + h * 64;
    const int vcol = PROB == 0 ? C_VA + (h >> 2) * 64 : C_VB + (PROB - 1) * 512 + h * 64;
    const int bh = PROB == 0 ? h : 8 + (PROB - 1) * 8 + h;
    for (int j = threadIdx.x; j < 2 * HW + 1; j += 256) sb[j] = rel_bias[t5_bucket((j - HW) * dil) * 32 + bh] * LOG2E;
    __syncthreads();
    float q[64], o[64];
    { const uint4* qp = (const uint4*)(QKV + (size_t)t * QKV_LD + qcol);
#pragma unroll
      for (int c = 0; c < 8; ++c) { const uint4 v = qp[c]; q[8 * c + 0] = bf2f(v.x & 0xffffu); q[8 * c + 1] = bf2f(v.x >> 16); q[8 * c + 2] = bf2f(v.y & 0xffffu); q[8 * c + 3] = bf2f(v.y >> 16);
          q[8 * c + 4] = bf2f(v.z & 0xffffu); q[8 * c + 5] = bf2f(v.z >> 16); q[8 * c + 6] = bf2f(v.w & 0xffffu); q[8 * c + 7] = bf2f(v.w >> 16); } }
#pragma unroll
    for (int i = 0; i < 64; ++i) o[i] = 0.f;
    float m = -1e30f, l = 0.f;
    for (int j = -HW; j <= HW; ++j) {
        const int s2 = s + j * dil; if (s2 < 0 || s2 >= SEQ) continue;
        const size_t rowoff = (size_t)(b * SEQ + s2) * QKV_LD;
        const uint4* kp = (const uint4*)(QKV + rowoff + kcol);
        float dot = 0.f;
#pragma unroll
        for (int c = 0; c < 8; ++c) { const uint4 v = kp[c];
            dot += q[8 * c + 0] * bf2f(v.x & 0xffffu) + q[8 * c + 1] * bf2f(v.x >> 16) + q[8 * c + 2] * bf2f(v.y & 0xffffu) + q[8 * c + 3] * bf2f(v.y >> 16)
                 + q[8 * c + 4] * bf2f(v.z & 0xffffu) + q[8 * c + 5] * bf2f(v.z >> 16) + q[8 * c + 6] * bf2f(v.w & 0xffffu) + q[8 * c + 7] * bf2f(v.w >> 16); }
        const float sc = dot + sb[j + HW];
        const float mn = fmaxf(m, sc), a = exp2f(m - mn), p = exp2f(sc - mn);
        l = l * a + p; m = mn;
        const uint4* vp = (const uint4*)(QKV + rowoff + vcol);
#pragma unroll
        for (int c = 0; c < 8; ++c) { const uint4 v = vp[c];
            o[8 * c + 0] = o[8 * c + 0] * a + p * bf2f(v.x & 0xffffu); o[8 * c + 1] = o[8 * c + 1] * a + p * bf2f(v.x >> 16); o[8 * c + 2] = o[8 * c + 2] * a + p * bf2f(v.y & 0xffffu); o[8 * c + 3] = o[8 * c + 3] * a + p * bf2f(v.y >> 16);
            o[8 * c + 4] = o[8 * c + 4] * a + p * bf2f(v.z & 0xffffu); o[8 * c + 5] = o[8 * c + 5] * a + p * bf2f(v.z >> 16); o[8 * c + 6] = o[8 * c + 6] * a + p * bf2f(v.w & 0xffffu); o[8 * c + 7] = o[8 * c + 7] * a + p * bf2f(v.w >> 16); }
    }
    float inv;
    if (PROB == 0) { const float sk = sink[h] * LOG2E; const float mn = fmaxf(m, sk); const float a = exp2f(m - mn); const float lt = l * a + exp2f(sk - mn); inv = a / lt; }
    else { inv = 1.f / l; LSE[(size_t)(PROB - 1) * MTOK * 8 + (size_t)t * 8 + h] = m + log2f(l); }
    uint4* op = (uint4*)(QKV + (size_t)t * QKV_LD + qcol);
#pragma unroll
    for (int c = 0; c < 8; ++c) {
        float r[8];
#pragma unroll
        for (int e = 0; e < 8; ++e) r[e] = o[8 * c + e] * inv;
        if (PROB == 0) { const uint4 g = ((const uint4*)(GAB + (size_t)t * 1024 + h * 64))[c]; const unsigned gw[4] = {g.x, g.y, g.z, g.w};
#pragma unroll
            for (int e = 0; e < 8; ++e) { const float gv = bf2f((e & 1) ? (gw[e >> 1] >> 16) : (gw[e >> 1] & 0xffffu)); r[e] *= gv / (1.f + __expf(-gv)); } }
        uint4 w; w.x = pk2(r[0], r[1]); w.y = pk2(r[2], r[3]); w.z = pk2(r[4], r[5]); w.w = pk2(r[6], r[7]); op[c] = w;
    }
}

__global__ __launch_bounds__(256) void p2c_combine(bf16_t* QKV, const bf16_t* __restrict__ GAB, const float* __restrict__ LSE) {
    const int lane = threadIdx.x & 63, wave = threadIdx.x >> 6;
    const int t = blockIdx.x * 4 + wave, h = lane >> 3;
    float ls[3], mx = -1e30f;
#pragma unroll
    for (int g = 0; g < 3; ++g) { ls[g] = LSE[(size_t)g * MTOK * 8 + (size_t)t * 8 + h]; mx = fmaxf(mx, ls[g]); }
    float al[3], sum = 0.f;
#pragma unroll
    for (int g = 0; g < 3; ++g) { al[g] = exp2f(ls[g] - mx); sum += al[g]; }
    const float inv = 1.f / sum;
    float r[8] = {0.f, 0.f, 0.f, 0.f, 0.f, 0.f, 0.f, 0.f};
#pragma unroll
    for (int g = 0; g < 3; ++g) { const uint4 v = *(const uint4*)(QKV + (size_t)t * QKV_LD + C_QB + g * 512 + lane * 8); const unsigned w[4] = {v.x, v.y, v.z, v.w}; const float a = al[g] * inv;
#pragma unroll
        for (int e = 0; e < 8; ++e) r[e] += a * bf2f((e & 1) ? (w[e >> 1] >> 16) : (w[e >> 1] & 0xffffu)); }
    { const uint4 g = *(const uint4*)(GAB + (size_t)t * 1024 + 512 + lane * 8); const unsigned gw[4] = {g.x, g.y, g.z, g.w};
#pragma unroll
      for (int e = 0; e < 8; ++e) { const float gv = bf2f((e & 1) ? (gw[e >> 1] >> 16) : (gw[e >> 1] & 0xffffu)); r[e] *= gv / (1.f + __expf(-gv)); } }
    uint4 w; w.x = pk2(r[0], r[1]); w.y = pk2(r[2], r[3]); w.z = pk2(r[4], r[5]); w.w = pk2(r[6], r[7]);
    *(uint4*)(QKV + (size_t)t * QKV_LD + 512 + lane * 8) = w;
}

__global__ __launch_bounds__(256) void p3_naive(const bf16_t* __restrict__ QKV, const float* __restrict__ Wa, const float* __restrict__ Wb, const bf16_t* __restrict__ Rb, const bf16_t* __restrict__ G1b, bf16_t* MER) {
    __shared__ float As[16 * 68], Bs[16 * 64];
    const int col0 = blockIdx.x * 64, row0 = blockIdx.y * 64, tid = threadIdx.x, ty = tid >> 4, tx = tid & 15;
    float aa[4][4] = {}, ab[4][4] = {};
    tile_gemm(aa, QKV + (size_t)row0 * QKV_LD, QKV_LD, Wa + col0, 1024, 512, As, Bs);
    tile_gemm(ab, QKV + (size_t)row0 * QKV_LD + 512, QKV_LD, Wb + col0, 1024, 512, As, Bs);
#pragma unroll
    for (int i = 0; i < 4; ++i) {
        const int row = row0 + ty * 4 + i; float v[4];
        const uint2 rr = *(const uint2*)(Rb + (size_t)row * 1024 + col0 + tx * 4), gg = *(const uint2*)(G1b + (size_t)row * 1024 + col0 + tx * 4);
        const float rv[4] = {bf2f(rr.x & 0xffffu), bf2f(rr.x >> 16), bf2f(rr.y & 0xffffu), bf2f(rr.y >> 16)}, gv[4] = {bf2f(gg.x & 0xffffu), bf2f(gg.x >> 16), bf2f(gg.y & 0xffffu), bf2f(gg.y >> 16)};
#pragma unroll
        for (int j = 0; j < 4; ++j) v[j] = gv[j] * (rv[j] * aa[i][j] + ab[i][j]);
        uint2 w; w.x = pk2(v[0], v[1]); w.y = pk2(v[2], v[3]); *(uint2*)(MER + (size_t)row * 1024 + col0 + tx * 4) = w;
    }
}
__global__ __launch_bounds__(256) void p4_naive(const bf16_t* __restrict__ MER, const float* __restrict__ Wout, const float* __restrict__ x, float* out) {
    __shared__ float As[16 * 68], Bs[16 * 64];
    const int col0 = blockIdx.x * 64, row0 = blockIdx.y * 64, tid = threadIdx.x, ty = tid >> 4, tx = tid & 15;
    float acc[4][4] = {};
    tile_gemm(acc, MER + (size_t)row0 * 1024, 1024, Wout + col0, 1024, 1024, As, Bs);
#pragma unroll
    for (int i = 0; i < 4; ++i) { const size_t off = (size_t)(row0 + ty * 4 + i) * 1024 + col0 + tx * 4; const float4 xv = *(const float4*)(x + off);
        *(float4*)(out + off) = make_float4(xv.x + acc[i][0], xv.y + acc[i][1], xv.z + acc[i][2], xv.w + acc[i][3]); }
}


#include <hip/hip_cooperative_groups.h>
namespace cg = cooperative_groups;
#define LAS __attribute__((address_space(3)))
typedef short bf16x8 __attribute__((ext_vector_type(8)));
typedef float f32x4 __attribute__((ext_vector_type(4)));
typedef float f32x2 __attribute__((ext_vector_type(2)));
typedef unsigned u32x4 __attribute__((ext_vector_type(4)));
typedef float f32x16 __attribute__((ext_vector_type(16)));
typedef short s16x4 __attribute__((ext_vector_type(4)));
typedef __bf16 bf16x2_t __attribute__((ext_vector_type(2)));
__device__ __forceinline__ unsigned cvtpk(float lo, float hi) { f32x2 v = {lo, hi}; bf16x2_t b = __builtin_convertvector(v, bf16x2_t); return __builtin_bit_cast(unsigned, b); }
__device__ __forceinline__ float bflo(unsigned w) { return __builtin_bit_cast(float, w << 16); }
__device__ __forceinline__ float bfhi(unsigned w) { return __builtin_bit_cast(float, w & 0xffff0000u); }


#ifndef PROBE
#define PROBE 0
#endif
#ifndef PROBE_MASK
#define PROBE_MASK 0
#endif
#ifndef PROBE_BX
#define PROBE_BX -1
#endif
struct Prof { unsigned long long tl, tp; unsigned acc[32]; };
#if PROBE
#define STAMP(pf, k) do { const unsigned long long _t = __builtin_amdgcn_s_memrealtime(); (pf).acc[k] += (unsigned)(_t - (pf).tl); (pf).tl = _t; } while (0)
#define PSTAMP(pf, k) do { const unsigned long long _t = __builtin_amdgcn_s_memrealtime(); (pf).acc[k] = (unsigned)(_t - (pf).tp); (pf).tl = _t; } while (0)
#define SSTAMP(pf, k) do { const unsigned long long _t = __builtin_amdgcn_s_memrealtime(); (pf).acc[k] = (unsigned)(_t - (pf).tl); (pf).tl = _t; (pf).tp = _t; } while (0)
#else
#define STAMP(pf, k) do { } while (0)
#define PSTAMP(pf, k) do { } while (0)
#define SSTAMP(pf, k) do { } while (0)
#endif
namespace pg8 {
constexpr int BM = 256, BK = 64, HALF = 128, HTB = HALF * BK * 2, STAGE_BYTES = 8 * HTB, NXCD = 8, WGM = 8;
__host__ __device__ __forceinline__ int lds_byte(int r, int c) { const int st = (r >> 4) * 2 + (c >> 5), rr = r & 15, cc = c & 31, ob = rr * 64 + cc * 2; return st * 1024 + (ob ^ (((ob >> 9) & 1) << 5)); }
__host__ __device__ __forceinline__ void stage_rc(int b, int& R, int& C) { const int st = b / 1024, sb = b % 1024, swz = sb ^ (((sb >> 9) & 1) << 5); R = (st >> 1) * 16 + swz / 64; C = (st & 1) * 32 + (swz % 64) / 2; }
__host__ __device__ __forceinline__ int perm32(int rho) { const int n = rho >> 4, i = rho & 15; return 8 * (i >> 2) + 4 * n + (i & 3); }
struct Unit { int pm, pn; };
struct Gemm { const bf16_t* A; const bf16_t* Bt; int M, N, K, lda; };
struct StaticOrder {
    int nM, nN, nwg, G, c;
    __host__ __device__ void init(int M, int N, int G_, int c_) { nM = M / BM; nN = N / BM; nwg = nM * nN; G = G_; c = c_; }
    __host__ __device__ bool next(int i, Unit& u) const {
        const long L = (long)i * G + c; if (L >= nwg) return false;
        int wgid = (int)L; { const int q = nwg / NXCD, r = nwg % NXCD, xcd = wgid % NXCD, off = wgid / NXCD; wgid = (xcd < r ? xcd * (q + 1) : r * (q + 1) + (xcd - r) * q) + off; }
        const int nig = WGM * nN, gid = wgid / nig, fm = gid * WGM, gsz = (nM - fm) < WGM ? (nM - fm) : WGM;
        u.pm = fm + ((wgid % nig) % gsz); u.pn = (wgid % nig) / gsz; return true;
    }
};
template <class Epi, bool ALIGN_EPI, int PB>
__device__ __forceinline__ void gemm_phase(LAS unsigned char* lds, const Gemm g, const StaticOrder& S, const Epi& E, Prof& pf) {
    const int tid = threadIdx.x, wid = __builtin_amdgcn_readfirstlane(tid >> 6), lane = tid & 63, wr = wid >> 2, wc = wid & 3, fr = lane & 15, fq = lane >> 4;
    const int K = g.K, nt = K / BK, lda = g.lda;
    unsigned voffA[2], voffB[2];
#pragma unroll
    for (int i = 0; i < 2; ++i) { int R, C; stage_rc(tid * 16 + i * 8192, R, C); const int Rb = Epi::PERM ? ((R & ~31) + perm32(R & 31)) : R;
        voffA[i] = (unsigned)(R * lda + C) * 2u; voffB[i] = (unsigned)(Rb * K + C) * 2u; }
    const size_t kstep = (size_t)(BK * 2);
    const size_t hstepA = (size_t)HALF * lda * 2, hstepB = (size_t)HALF * K * 2;
    const size_t tstepA = 2 * hstepA, tstepB = 2 * hstepB;
    const unsigned ldsw = (unsigned)wid * 1024u;
    const int aoff = lds_byte(wr * 64 + fr, fq * 8), boff = lds_byte(wc * 32 + fr, fq * 8);
#define PG8_SA(b, h) (((b) * 2 + (h)) * HTB)
#define PG8_SB(b, h) ((4 + (b) * 2 + (h)) * HTB)
#define PG8_STAGE(bufoff, gbase, voff) do { _Pragma("unroll") for (int _i = 0; _i < 2; ++_i) \
        __builtin_amdgcn_global_load_lds((const unsigned*)((const char*)(gbase) + (voff)[_i]), (LAS unsigned*)(lds + (bufoff) + ldsw + _i * 8192), 16, 0, 0); } while (0)
#define PG8_LDA(dst, b, h) do { _Pragma("unroll") for (int m = 0; m < 4; ++m) _Pragma("unroll") for (int k = 0; k < 2; ++k) dst[m][k] = *(const LAS bf16x8*)(lds + PG8_SA(b, h) + aoff + m * 2048 + k * 1024); } while (0)
#define PG8_LDB(dst, b, h) do { _Pragma("unroll") for (int n = 0; n < 2; ++n) _Pragma("unroll") for (int k = 0; k < 2; ++k) dst[n][k] = *(const LAS bf16x8*)(lds + PG8_SB(b, h) + boff + n * 2048 + k * 1024); } while (0)
#define PG8_MMA(ai, bj, At, Bt) do { __builtin_amdgcn_s_setprio(1); _Pragma("unroll") for (int m = 0; m < 4; ++m) _Pragma("unroll") for (int n = 0; n < 2; ++n) _Pragma("unroll") for (int k = 0; k < 2; ++k) \
        acc[ai][bj][m][n] = __builtin_amdgcn_mfma_f32_16x16x32_bf16(Bt[n][k], At[m][k], acc[ai][bj][m][n], 0, 0, 0); __builtin_amdgcn_s_setprio(0); } while (0)
#define PG8_WAIT_V(n) asm volatile("s_waitcnt vmcnt(" #n ")" ::: "memory")
#define PG8_WAIT_L(n) asm volatile("s_waitcnt lgkmcnt(" #n ")" ::: "memory")
#define PG8_BAR __builtin_amdgcn_s_barrier()
#define PG8_SCHED __builtin_amdgcn_sched_barrier(0)
    Unit cur, nxt; int ui = 0;
    if (!S.next(0, cur)) return;
    f32x4 acc[2][2][4][2];
#pragma unroll
    for (int a = 0; a < 2; ++a)
#pragma unroll
        for (int b = 0; b < 2; ++b)
#pragma unroll
            for (int m = 0; m < 4; ++m)
#pragma unroll
                for (int n = 0; n < 2; ++n) acc[a][b][m][n] = (f32x4){0.f, 0.f, 0.f, 0.f};
    bf16x8 At[4][2], B0[2][2], B1[2][2];
    const char* cA = (const char*)g.A + (size_t)cur.pm * tstepA; const char* cB = (const char*)g.Bt + (size_t)cur.pn * tstepB;
    PG8_STAGE(PG8_SB(0, 0), cB, voffB); PG8_STAGE(PG8_SB(0, 1), cB + hstepB, voffB); PG8_STAGE(PG8_SA(0, 0), cA, voffA); PG8_STAGE(PG8_SA(0, 1), cA + hstepA, voffA);
    if (wr == 1) PG8_BAR;
    PG8_WAIT_V(2); PG8_BAR;
    PG8_STAGE(PG8_SB(1, 0), cB + kstep, voffB); PG8_STAGE(PG8_SA(1, 0), cA + kstep, voffA); PG8_STAGE(PG8_SB(1, 1), cB + hstepB + kstep, voffB);
    PG8_WAIT_V(6); PG8_BAR;
    for (;;) {
        const bool has_next = S.next(ui + 1, nxt);
        const char* nA = has_next ? (const char*)g.A + (size_t)nxt.pm * tstepA : cA; const char* nB = has_next ? (const char*)g.Bt + (size_t)nxt.pn * tstepB : cB;
        for (int t = 0; t < nt; t += 2) {
            if constexpr (Epi::HAS_MID) { if (t == nt / 2) { STAMP(pf, PB); E.mid(acc, cur, wr, wc, fr, fq); STAMP(pf, PB + 3); } }
            const bool last = (t == nt - 2);
            const char* a1 = cA + (size_t)(t + 1) * kstep;
            const char* a2 = last ? nA : cA + (size_t)(t + 2) * kstep; const char* b2 = last ? nB : cB + (size_t)(t + 2) * kstep;
            const char* a3 = a2 + kstep; const char* b3 = b2 + kstep;
            PG8_LDB(B0, 0, 0); PG8_LDB(B1, 0, 1); PG8_SCHED; PG8_LDA(At, 0, 0); PG8_STAGE(PG8_SA(1, 1), a1 + hstepA, voffA);
            PG8_WAIT_V(8); PG8_WAIT_L(0); PG8_BAR; PG8_MMA(0, 0, At, B0); PG8_MMA(0, 1, At, B1); PG8_BAR; PG8_SCHED;
            PG8_LDA(At, 0, 1); PG8_STAGE(PG8_SB(0, 0), b2, voffB); PG8_STAGE(PG8_SB(0, 1), b2 + hstepB, voffB); PG8_STAGE(PG8_SA(0, 0), a2, voffA);
            PG8_WAIT_V(8); PG8_WAIT_L(0); PG8_BAR; PG8_MMA(1, 0, At, B0); PG8_MMA(1, 1, At, B1); PG8_BAR; PG8_SCHED;
            PG8_LDB(B0, 1, 0); PG8_LDB(B1, 1, 1); PG8_SCHED; PG8_LDA(At, 1, 0); PG8_STAGE(PG8_SA(0, 1), a2 + hstepA, voffA);
            PG8_WAIT_V(8); PG8_WAIT_L(0); PG8_BAR; PG8_MMA(0, 0, At, B0); PG8_MMA(0, 1, At, B1); PG8_BAR; PG8_SCHED;
            PG8_LDA(At, 1, 1); PG8_STAGE(PG8_SB(1, 0), b3, voffB); PG8_STAGE(PG8_SB(1, 1), b3 + hstepB, voffB); PG8_STAGE(PG8_SA(1, 0), a3, voffA);
            PG8_WAIT_V(8); PG8_WAIT_L(0); PG8_BAR; PG8_MMA(1, 0, At, B0); PG8_MMA(1, 1, At, B1); PG8_BAR; PG8_SCHED;
        }
        STAMP(pf, PB);
        if constexpr (ALIGN_EPI) { if (wr == 0) PG8_BAR; }
        STAMP(pf, PB + 2);
        E(acc, cur, wr, wc, fr, fq);
        STAMP(pf, PB + 1);
#ifdef EPI_TWICE
        asm volatile("" ::: "memory"); E(acc, cur, wr, wc, fr, fq);
#endif
        if (!has_next) break;
#pragma unroll
        for (int a = 0; a < 2; ++a)
#pragma unroll
            for (int b = 0; b < 2; ++b)
#pragma unroll
                for (int m = 0; m < 4; ++m)
#pragma unroll
                    for (int n = 0; n < 2; ++n) acc[a][b][m][n] = (f32x4){0.f, 0.f, 0.f, 0.f};
        cur = nxt; cA = nA; cB = nB; ++ui;
        if constexpr (ALIGN_EPI) { if (wr == 1) PG8_BAR; }
    }
    PG8_WAIT_V(0);
    if constexpr (!ALIGN_EPI) { if (wr == 0) PG8_BAR; }
    PG8_BAR;
#undef PG8_SA
#undef PG8_SB
#undef PG8_STAGE
#undef PG8_LDA
#undef PG8_LDB
#undef PG8_MMA
#undef PG8_WAIT_V
#undef PG8_WAIT_L
#undef PG8_BAR
#undef PG8_SCHED
}
}

#ifndef EPI_FENCE5
#define EPI_FENCE5 1
#endif
#ifndef EPI_FENCE4
#define EPI_FENCE4 1
#endif
struct EpiP1 {
    static constexpr bool PERM = true, HAS_MID = false;
    bf16_t* QKV; bf16_t* GAB; bf16_t* Rb; bf16_t* G1b; const float *qna, *kna, *qnb, *knb, *bm;
    __device__ __forceinline__ void operator()(const f32x4 (&acc)[2][2][4][2], const pg8::Unit& u, int wr, int wc, int fr, int fq) const {
        const int row0 = u.pm * 256 + wr * 64 + fr;
        if (u.pn < 25) {
            const int hc0 = u.pn * 256 + wc * 64;
            const float* gain = nullptr; float sc = 1.f;
            if (hc0 < C_KA) { gain = qna; sc = QSCALE; } else if (hc0 < C_VA) { gain = kna; } else if (hc0 < C_QB) { } else if (hc0 < C_KB) { gain = qnb; sc = QSCALE; } else if (hc0 < C_VB) { gain = knb; }
            f32x4 gv[2][2];
#pragma unroll
            for (int bj = 0; bj < 2; ++bj)
#pragma unroll
                for (int n = 0; n < 2; ++n) gv[bj][n] = gain ? *(const f32x4*)(gain + 32 * bj + 8 * fq + 4 * n) * sc : (f32x4){1.f, 1.f, 1.f, 1.f};
            bf16_t* base; int ld;
            if (hc0 < C_GA) { base = QKV + hc0; ld = QKV_LD; } else { base = GAB + (hc0 - C_GA); ld = 1024; }
#pragma unroll
            for (int ai = 0; ai < 2; ++ai)
#pragma unroll
                for (int m = 0; m < 4; ++m) {
                    float rstd = 1.f;
                    if (gain) {
                        float ss = 0.f;
#pragma unroll
                        for (int bj = 0; bj < 2; ++bj)
#pragma unroll
                            for (int n = 0; n < 2; ++n) { const f32x4 x = acc[ai][bj][m][n]; ss += (x[0] * x[0] + x[1] * x[1]) + (x[2] * x[2] + x[3] * x[3]); }
                        ss += __shfl_xor(ss, 16); ss += __shfl_xor(ss, 32);
                        rstd = rsqrtf(ss * (1.f / 64.f) + EPS);
                    }
                    bf16_t* rowp = base + (size_t)(row0 + ai * 128 + m * 16) * ld + 8 * fq;
#pragma unroll
                    for (int bj = 0; bj < 2; ++bj) { const f32x4 v0 = acc[ai][bj][m][0] * gv[bj][0] * rstd, v1 = acc[ai][bj][m][1] * gv[bj][1] * rstd;
                        u32x4 w; w.x = cvtpk(v0[0], v0[1]); w.y = cvtpk(v0[2], v0[3]); w.z = cvtpk(v1[0], v1[1]); w.w = cvtpk(v1[2], v1[3]);
                        *(u32x4*)(rowp + 32 * bj) = w; }
                }
        } else {
            const int c0 = 128 * (u.pn - 25) + wc * 32 + 8 * fq;
            f32x4 b0[2], b1[2];
#pragma unroll
            for (int n = 0; n < 2; ++n) { b0[n] = *(const f32x4*)(bm + c0 + 4 * n); b1[n] = *(const f32x4*)(bm + 1024 + c0 + 4 * n); }
#pragma unroll
            for (int ai = 0; ai < 2; ++ai)
#pragma unroll
                for (int m = 0; m < 4; ++m) {
                    const size_t off = (size_t)(row0 + ai * 128 + m * 16) * 1024 + c0;
                    float r[8], g[8];
#pragma unroll
                    for (int n = 0; n < 2; ++n)
#pragma unroll
                        for (int j = 0; j < 4; ++j) { const float z0 = acc[ai][0][m][n][j] + b0[n][j], z1 = acc[ai][1][m][n][j] + b1[n][j];
                            const float e0 = 1.f + __expf(-z0), e1 = 1.f + __expf(-z1); const float g1 = __builtin_amdgcn_rcpf(e1);
                            g[4 * n + j] = g1; r[4 * n + j] = e1 * __builtin_amdgcn_rcpf(e0); }
                    u32x4 w; w.x = cvtpk(r[0], r[1]); w.y = cvtpk(r[2], r[3]); w.z = cvtpk(r[4], r[5]); w.w = cvtpk(r[6], r[7]); *(u32x4*)(Rb + off) = w;
                    w.x = cvtpk(g[0], g[1]); w.y = cvtpk(g[2], g[3]); w.z = cvtpk(g[4], g[5]); w.w = cvtpk(g[6], g[7]); *(u32x4*)(G1b + off) = w;
                }
        }
    }
};
struct EpiP4 {
    static constexpr bool PERM = true, HAS_MID = true;
    const bf16_t* Rb; const bf16_t* G1b; bf16_t* MER;
    __device__ __forceinline__ void mid(f32x4 (&acc)[2][2][4][2], const pg8::Unit& u, int wr, int wc, int fr, int fq) const {
        const int row0 = u.pm * 256 + wr * 64 + fr, col0 = u.pn * 256 + wc * 32 + 8 * fq;
        const bf16_t* rb = Rb + (size_t)row0 * 1024 + col0; asm volatile("" : "+v"(rb));
#pragma unroll
        for (int ai = 0; ai < 2; ++ai)
#pragma unroll
            for (int m = 0; m < 4; ++m)
#pragma unroll
                for (int bj = 0; bj < 2; ++bj) { const u32x4 w = *(const __attribute__((address_space(1))) u32x4*)(rb + (size_t)(ai * 128 + m * 16) * 1024 + bj * 128);
                    acc[ai][bj][m][0] *= (f32x4){bflo(w.x), bfhi(w.x), bflo(w.y), bfhi(w.y)}; acc[ai][bj][m][1] *= (f32x4){bflo(w.z), bfhi(w.z), bflo(w.w), bfhi(w.w)};
                    if (EPI_FENCE4 && bj == 1 && m == 3) asm volatile("" ::: "memory"); }
    }
    __device__ __forceinline__ void operator()(const f32x4 (&acc)[2][2][4][2], const pg8::Unit& u, int wr, int wc, int fr, int fq) const {
        const int row0 = u.pm * 256 + wr * 64 + fr, col0 = u.pn * 256 + wc * 32 + 8 * fq;
#pragma unroll
        for (int ai = 0; ai < 2; ++ai)
#pragma unroll
            for (int m = 0; m < 4; ++m)
#pragma unroll
                for (int bj = 0; bj < 2; ++bj) { const size_t off = (size_t)(row0 + ai * 128 + m * 16) * 1024 + col0 + bj * 128; const u32x4 w = *(const u32x4*)(G1b + off);
                    const f32x4 v0 = acc[ai][bj][m][0] * (f32x4){bflo(w.x), bfhi(w.x), bflo(w.y), bfhi(w.y)}, v1 = acc[ai][bj][m][1] * (f32x4){bflo(w.z), bfhi(w.z), bflo(w.w), bfhi(w.w)};
                    u32x4 o; o.x = cvtpk(v0[0], v0[1]); o.y = cvtpk(v0[2], v0[3]); o.z = cvtpk(v1[0], v1[1]); o.w = cvtpk(v1[2], v1[3]); *(u32x4*)(MER + off) = o;
                    if (EPI_FENCE4 && bj == 1 && m == 3) asm volatile("" ::: "memory"); }
    }
};
struct EpiP5 {
    static constexpr bool PERM = false, HAS_MID = false;
    const float* x; float* out;
    __device__ __forceinline__ void operator()(const f32x4 (&acc)[2][2][4][2], const pg8::Unit& u, int wr, int wc, int fr, int fq) const {
        const int row0 = u.pm * 256 + wr * 64 + fr, col0 = u.pn * 256 + wc * 32 + 4 * fq;
#pragma unroll
        for (int ai = 0; ai < 2; ++ai)
#pragma unroll
            for (int m = 0; m < 4; ++m) {
#pragma unroll
                for (int bj = 0; bj < 2; ++bj)
#pragma unroll
                    for (int n = 0; n < 2; ++n) { const size_t off = (size_t)(row0 + ai * 128 + m * 16) * 1024 + col0 + bj * 128 + n * 16; *(f32x4*)(out + off) = *(const f32x4*)(x + off) + acc[ai][bj][m][n]; }
                if (EPI_FENCE5 && m == 3) asm volatile("" ::: "memory");
            }
    }
};

constexpr int RING_BYTES = 131072, TAB_OFF = RING_BYTES, WSF_OFF = TAB_OFF + 6144, LDS_BYTES = WSF_OFF + 2048 + 1024;

__device__ __forceinline__ void p0_transpose_item(const float* W, int N, bf16_t* WT, int ldt, int koff, int drow0, LAS float* scr, int k0, int n0, int lane) {
#pragma unroll 8
    for (int i = 0; i < 32; ++i) { const int kk = 2 * i + (lane >> 5); scr[kk * 33 + (lane & 31)] = W[(size_t)(k0 + kk) * N + n0 + (lane & 31)]; }
    asm volatile("s_waitcnt lgkmcnt(0)" ::: "memory");
    const int c = lane & 7;
#pragma unroll
    for (int j = 0; j < 4; ++j) { const int n = (lane >> 3) + 8 * j; const LAS float* s = scr + (8 * c) * 33 + n;
        u32x4 o; o.x = pk2(s[0 * 33], s[1 * 33]); o.y = pk2(s[2 * 33], s[3 * 33]); o.z = pk2(s[4 * 33], s[5 * 33]); o.w = pk2(s[6 * 33], s[7 * 33]);
        *(u32x4*)(WT + (size_t)(drow0 + n) * ldt + koff + k0 + 8 * c) = o; }
    asm volatile("s_waitcnt lgkmcnt(0)" ::: "memory");
}
__device__ __forceinline__ int win_dest_row(int n0) {
    if (n0 < C_MG) { const int pn = n0 >> 8, rem = n0 & 255; return 256 * pn + 128 * ((rem >> 5) & 1) + 32 * (rem >> 6); }
    const int mc = n0 - C_MG, bj = mc >> 10, c = mc & 1023; return 256 * (25 + (c >> 7)) + 128 * bj + 32 * ((c & 127) >> 5);
}
struct Ptrs {
    const float *x, *gain, *Win, *qna, *kna, *qnb, *knb, *sink, *relb, *Wa, *Wb, *bm, *Wout; float* out;
    bf16_t *WinT, *WabT, *WoutT, *XN, *MER, *GAB, *QKV, *Rb, *G1b; float *LSE, *TABG, *CH;
};
__device__ __forceinline__ void p0_prologue(LAS unsigned char* lds, const Ptrs& P, int vcu, int G, int wave, int lane) {
    LAS float* scr = (LAS float*)(lds + wave * 16384);
    const int gw = vcu * 8 + wave, NGW = G * 8;
    constexpr int I_IN = 16 * (NIN / 32), I_A = 8 * 32, I_B = 8 * 32, I_O = 16 * 32, NITEMS = I_IN + I_A + I_B + I_O;
    if (vcu < 32) {
        const int ht = vcu, isA = ht < 8, g = isA ? 0 : (ht - 8) >> 3, dsh = 2 * g, HW = isA ? 128 : 64;
        const float* gq = isA ? P.qna : P.qnb; const float* gk = isA ? P.kna : P.knb;
        float a = fabsf(gq[lane]), b = fabsf(gk[lane]), c = lane < 32 ? fabsf(P.relb[lane * 32 + ht]) : 0.f;
#pragma unroll
        for (int sft = 1; sft < 64; sft <<= 1) { a = fmaxf(a, __shfl_xor(a, sft)); b = fmaxf(b, __shfl_xor(b, sft)); c = fmaxf(c, __shfl_xor(c, sft)); }
        const float C = 64.f * QSCALE * a * b * 1.02f + c * LOG2E + 0.5f;
        if (lane == 0 && wave == 0) P.CH[ht] = C;
        if (lane < 48) { const int e = wave * 48 + lane, rel = e - 191, arel = rel < 0 ? -rel : rel;
            P.TABG[ht * 384 + e] = (arel <= HW) ? P.relb[t5_bucket(rel << dsh) * 32 + ht] * LOG2E - C : -1e30f; }
    }
    for (int it = gw; it < NITEMS; it += NGW) {
        int r = it;
        if (r < I_IN) { const int kb = r / (NIN / 32), nb = r % (NIN / 32); p0_transpose_item(P.Win, NIN, P.WinT, 1024, 0, win_dest_row(32 * nb), scr, 64 * kb, 32 * nb, lane); continue; } r -= I_IN;
        if (r < I_A) { const int kb = r >> 5, nb = r & 31; p0_transpose_item(P.Wa, 1024, P.WabT, 1024, 0, 32 * nb, scr, 64 * kb, 32 * nb, lane); continue; } r -= I_A;
        if (r < I_B) { const int kb = r >> 5, nb = r & 31; p0_transpose_item(P.Wb, 1024, P.WabT, 1024, 512, 32 * nb, scr, 64 * kb, 32 * nb, lane); continue; } r -= I_B;
        { const int kb = r >> 5, nb = r & 31; p0_transpose_item(P.Wout, 1024, P.WoutT, 1024, 0, 32 * nb, scr, 64 * kb, 32 * nb, lane); }
    }
    for (int row = gw; row < MTOK; row += 2 * NGW) {
        const int row2 = row + NGW;
        const bool has2 = row2 < MTOK;
        const float4* xr = (const float4*)(P.x + (size_t)row * DM) + lane; const float4* xr2 = (const float4*)(P.x + (size_t)(has2 ? row2 : row) * DM) + lane;
        float4 v[4], u[4]; float s = 0.f, s2 = 0.f;
#pragma unroll
        for (int j = 0; j < 4; ++j) { v[j] = xr[64 * j]; u[j] = xr2[64 * j]; }
#pragma unroll
        for (int j = 0; j < 4; ++j) { s += (v[j].x * v[j].x + v[j].y * v[j].y) + (v[j].z * v[j].z + v[j].w * v[j].w); s2 += (u[j].x * u[j].x + u[j].y * u[j].y) + (u[j].z * u[j].z + u[j].w * u[j].w); }
#pragma unroll
        for (int o = 1; o < 64; o <<= 1) { s += __shfl_xor(s, o); s2 += __shfl_xor(s2, o); }
        const float rstd = rsqrtf(s * (1.f / DM) + EPS), rstd2 = rsqrtf(s2 * (1.f / DM) + EPS);
        uint2* o8 = (uint2*)(P.XN + (size_t)row * DM) + lane; uint2* o82 = (uint2*)(P.XN + (size_t)row2 * DM) + lane;
#pragma unroll
        for (int j = 0; j < 4; ++j) { const float4 g = ((const float4*)P.gain)[lane + 64 * j];
            uint2 w; w.x = cvtpk(v[j].x * rstd * g.x, v[j].y * rstd * g.y); w.y = cvtpk(v[j].z * rstd * g.z, v[j].w * rstd * g.w); o8[64 * j] = w;
            if (has2) { uint2 w2; w2.x = cvtpk(u[j].x * rstd2 * g.x, u[j].y * rstd2 * g.y); w2.y = cvtpk(u[j].z * rstd2 * g.z, u[j].w * rstd2 * g.w); o82[64 * j] = w2; } }
    }
}

namespace att {
__device__ __forceinline__ void glds16(const void* gsrc, unsigned lds_dst) { unsigned keep;
    asm volatile("s_mov_b32 %0, m0\n\ts_mov_b32 m0, %2\n\ts_nop 0\n\tglobal_load_lds_dwordx4 %1, off\n\ts_mov_b32 m0, %0" : "=&s"(keep) : "v"(gsrc), "s"(lds_dst) : "memory"); }
struct UnitP { int prob, dsh, b, c, ub  , qcol0, kcol0, vcol0, bh0, key, seq, uidx  , jlo, jhi, nj; };
__device__ __forceinline__ UnitP decode(int ui, int vcu) {
    UnitP U;
    if (ui < 4) { const int j = 4 * vcu + ui; U.prob = 0; U.dsh = 0; U.uidx = j & 63; const int kvh = (j >> 6) & 1; U.b = j >> 7; U.c = 0; U.ub = 64 * U.uidx;
        U.qcol0 = C_QA + 4 * kvh * 64; U.kcol0 = C_KA + kvh * 64; U.vcol0 = C_VA + kvh * 64; U.bh0 = 4 * kvh; U.key = kvh; U.seq = j >> 6; U.nj = 64;
        U.jlo = U.uidx - 2 > 0 ? U.uidx - 2 : 0; U.jhi = U.uidx + 2 < 63 ? U.uidx + 2 : 63; }
    else { const int jb = 12 * vcu + (ui - 4), g = jb >> 10, j = jb & 1023; U.prob = 1 + g; U.dsh = 2 * g; const int nus = 5 - U.dsh; U.uidx = j & ((1 << nus) - 1); int rest = j >> nus; const int hp = rest & 3; rest >>= 2; U.c = rest & ((1 << U.dsh) - 1); U.b = rest >> U.dsh;
        U.ub = 128 * U.uidx; U.qcol0 = C_QB + g * 512 + 2 * hp * 64; U.kcol0 = C_KB + g * 512 + 2 * hp * 64; U.vcol0 = C_VB + g * 512 + 2 * hp * 64; U.bh0 = 8 + 8 * g + 2 * hp; U.key = 2 + 4 * g + hp; U.seq = 1024 + (jb >> nus); U.nj = SEQ >> (U.dsh + 6);
        U.jlo = 2 * U.uidx - 1 > 0 ? 2 * U.uidx - 1 : 0; U.jhi = 2 * U.uidx + 2 < U.nj - 1 ? 2 * U.uidx + 2 : U.nj - 1; }
    return U;
}
__device__ __forceinline__ void dma_tile(const bf16_t* QKV, const UnitP& U, int j, unsigned sb, int wid, int lane) {
    const size_t rowb = (size_t)U.b * SEQ; const int nslot = U.prob == 0 ? 1 : 2;
    const int row = 8 * wid + (lane >> 3), cp = lane & 7;
    const bf16_t* rp = QKV + (rowb + (size_t)((64 * j + row) << U.dsh) + U.c) * QKV_LD;
    const bf16_t* ks = rp + U.kcol0 + ((cp ^ (lane >> 3)) << 3);
    const bf16_t* vs = rp + U.vcol0 + (((((cp >> 2) ^ (lane >> 4)) & 1) << 2 | (cp & 3)) << 3);
    for (int s = 0; s < nslot; ++s) {
        glds16(ks + s * 64, (unsigned)__builtin_amdgcn_readfirstlane(sb + s * 16384 + wid * 1024));
        glds16(vs + s * 64, (unsigned)__builtin_amdgcn_readfirstlane(sb + s * 16384 + 8192 + wid * 1024));
    }
}
__device__ __forceinline__ void att_step(const bool FAST, f32x16 (&o)[2], f32x16& ol, float& mrun, const bf16x8 (&qr)[4], const LAS float* tb, const LAS unsigned char* kb, int vbb, int hi, int r32, int lane, bf16x8 ones) {
    f32x16 p0, p1; bf16x8 kf[8]; s16x4 vlo[2][4], vhh[2][4];
#pragma unroll
    for (int r = 0; r < 16; ++r) { p0[r] = tb[(r & 3) + 8 * (r >> 2)]; p1[r] = tb[32 + (r & 3) + 8 * (r >> 2)]; }
#pragma unroll
    for (int d0 = 0; d0 < 4; ++d0) { const int ko = ((2 * d0 + hi) ^ (r32 & 7)) << 4; kf[2 * d0] = *(const LAS bf16x8*)(kb + ko); kf[2 * d0 + 1] = *(const LAS bf16x8*)(kb + ko + 4096); }
    const int vq = (lane & 15) >> 2, vb0 = vbb + ((vq >> 1) & 1) * 64, vb1 = vbb + (((vq >> 1) & 1) ^ 1) * 64;
#pragma unroll
    for (int d0 = 0; d0 < 2; ++d0) { const int vb = d0 ? vb1 : vb0;
#pragma unroll
        for (int ks = 0; ks < 4; ++ks) {
            asm volatile("ds_read_b64_tr_b16 %0,%1 offset:%c2" : "=&v"(vlo[d0][ks]) : "v"(vb), "i"(ks * 2048) : "memory");
            asm volatile("ds_read_b64_tr_b16 %0,%1 offset:%c2" : "=&v"(vhh[d0][ks]) : "v"(vb), "i"(ks * 2048 + 1024) : "memory"); } }
    asm volatile("s_waitcnt lgkmcnt(0)" ::: "memory"); __builtin_amdgcn_sched_barrier(0);
#pragma unroll
    for (int d0 = 0; d0 < 4; ++d0) { p0 = __builtin_amdgcn_mfma_f32_32x32x16_bf16(kf[2 * d0], qr[d0], p0, 0, 0, 0); p1 = __builtin_amdgcn_mfma_f32_32x32x16_bf16(kf[2 * d0 + 1], qr[d0], p1, 0, 0, 0); }
    if (!FAST) {
        float rm = fmaxf(p0[0], p1[0]);
#pragma unroll
        for (int r = 1; r < 16; ++r) rm = fmaxf(rm, fmaxf(p0[r], p1[r]));
        { auto rr = __builtin_amdgcn_permlane32_swap(__float_as_uint(rm), __float_as_uint(rm), false, false); rm = fmaxf(__uint_as_float(rr[0]), __uint_as_float(rr[1])); }
        const float mn = fmaxf(mrun, rm), alpha = __builtin_amdgcn_exp2f(mrun - mn); mrun = mn;
        o[0] *= alpha; o[1] *= alpha; ol *= alpha;
#pragma unroll
        for (int r = 0; r < 16; ++r) { p0[r] -= mn; p1[r] -= mn; }
    }
#pragma unroll
    for (int r = 0; r < 16; ++r) { p0[r] = __builtin_amdgcn_exp2f(p0[r]); p1[r] = __builtin_amdgcn_exp2f(p1[r]); }
    u32x4 pw[4];
    pw[0] = (u32x4){cvtpk(p0[0], p0[1]), cvtpk(p0[2], p0[3]), cvtpk(p0[4], p0[5]), cvtpk(p0[6], p0[7])};
    pw[1] = (u32x4){cvtpk(p0[8], p0[9]), cvtpk(p0[10], p0[11]), cvtpk(p0[12], p0[13]), cvtpk(p0[14], p0[15])};
    pw[2] = (u32x4){cvtpk(p1[0], p1[1]), cvtpk(p1[2], p1[3]), cvtpk(p1[4], p1[5]), cvtpk(p1[6], p1[7])};
    pw[3] = (u32x4){cvtpk(p1[8], p1[9]), cvtpk(p1[10], p1[11]), cvtpk(p1[12], p1[13]), cvtpk(p1[14], p1[15])};
#pragma unroll
    for (int ks = 0; ks < 4; ++ks) ol = __builtin_amdgcn_mfma_f32_32x32x16_bf16(ones, __builtin_bit_cast(bf16x8, pw[ks]), ol, 0, 0, 0);
#pragma unroll
    for (int d0 = 0; d0 < 2; ++d0)
#pragma unroll
        for (int ks = 0; ks < 4; ++ks) { const bf16x8 vf = (bf16x8){vlo[d0][ks][0], vlo[d0][ks][1], vlo[d0][ks][2], vlo[d0][ks][3], vhh[d0][ks][0], vhh[d0][ks][1], vhh[d0][ks][2], vhh[d0][ks][3]};
            o[d0] = __builtin_amdgcn_mfma_f32_32x32x16_bf16(vf, __builtin_bit_cast(bf16x8, pw[ks]), o[d0], 0, 0, 0); }
}
#define ATT_WAIT_BAR() do { asm volatile("s_waitcnt vmcnt(0) lgkmcnt(0)" ::: "memory"); __builtin_amdgcn_s_barrier(); } while (0)
#define ATT_BAR() do { asm volatile("s_waitcnt lgkmcnt(0)" ::: "memory"); __builtin_amdgcn_s_barrier(); } while (0)
__device__ __forceinline__ void attn_phase(LAS unsigned char* lds, const Ptrs& P, int vcu, int dry, Prof& pf) {
    const int tid = threadIdx.x, lane = tid & 63, r32 = lane & 31, hi = lane >> 5;
    const int wid = __builtin_amdgcn_readfirstlane(tid >> 6);
    const unsigned lds0 = (unsigned)(uintptr_t)lds;
    LAS float* tabs = (LAS float*)(lds + TAB_OFF);
    bf16_t* QKV = P.QKV;
    const short one = (r32 == 0) ? (short)0x3F80 : (short)0; const bf16x8 ones = (bf16x8){one, one, one, one, one, one, one, one};
    int tab_key = -1, prev_seq = -1, prev_u = -100; float Ch = 0.f; bool fast = true;
    unsigned pim = 0u;
    UnitP U = decode(0, vcu);
#define WAVE_ROLE(UU, hs_, qoff_) const int hs_ = (UU).prob == 0 ? (wid >> 1) : ((wid >> 1) & 1); const int qoff_ = (UU).prob == 0 ? 32 * (wid & 1) : 32 * (2 * (wid >> 2) + (wid & 1))
    bf16x8 qn[4];
    { WAVE_ROLE(U, hs0, qo0); const bf16_t* Qn = QKV + ((size_t)U.b * SEQ + (size_t)((U.ub + qo0 + r32) << U.dsh) + U.c) * QKV_LD + U.qcol0 + hs0 * 64;
#pragma unroll
      for (int d0 = 0; d0 < 4; ++d0) qn[d0] = *(const bf16x8*)(Qn + d0 * 16 + hi * 8); }
    for (int ui = 0; ui < 16; ++ui) {
        const UnitP N = decode(ui + 1 < 16 ? ui + 1 : ui, vcu);
        const int dsh = U.dsh, prob = U.prob;
        const bool fresh = !(U.seq == prev_seq && U.uidx == prev_u + 1);
        const bool ncont = (ui + 1 < 16) && N.seq == U.seq && N.uidx == U.uidx + 1;
        WAVE_ROLE(U, hs, qoff);
        const LAS float* tab = tabs + hs * 384;
        STAMP(pf, 5);
        if (fresh) ATT_BAR();
        if (U.key != tab_key) {
            const int nt = (prob == 0 ? 4 : 2) * 384;
            for (int e = tid; e < nt; e += 512) tabs[e] = P.TABG[U.bh0 * 384 + e];
            tab_key = U.key; Ch = P.CH[U.bh0 + hs]; fast = Ch <= 60.f;
        }
        STAMP(pf, 0);
        const size_t rowb = (size_t)U.b * SEQ;
        const int mqb = U.ub + qoff, qcol = U.qcol0 + hs * 64;
        bf16_t* Qrow = QKV + (rowb + (size_t)((mqb + r32) << dsh) + U.c) * QKV_LD + qcol;
        bf16x8 qr[4];
#pragma unroll
        for (int d0 = 0; d0 < 4; ++d0) { qr[d0] = qn[d0]; asm volatile("" : "+v"(qr[d0])); }
        STAMP(pf, 2);
        const size_t grow = rowb + (size_t)((mqb + r32) << dsh) + U.c;
        uint2 gav[8];
        if (prob == 0) {
#pragma unroll
            for (int d0 = 0; d0 < 2; ++d0)
#pragma unroll
                for (int gp = 0; gp < 2; ++gp) { const bf16_t* gp0 = P.GAB + grow * 1024 + (U.bh0 + hs) * 64 + 32 * d0 + 16 * gp + 4 * hi; gav[4 * d0 + 2 * gp] = *(const uint2*)gp0; gav[4 * d0 + 2 * gp + 1] = *(const uint2*)(gp0 + 8); }
        }
        float mrun = -1e30f; f32x16 o[2], ol; o[0] = f32x16{}; o[1] = f32x16{}; ol = f32x16{};
        const int jbase = (U.uidx & ~3) - 2;
        if (fresh) {
            if (dry != 2) { if (prob == 0) { const int ja = jbase > 0 ? jbase : 0, jz = (jbase + 7) < 63 ? (jbase + 7) : 63; for (int j = ja; j <= jz; ++j) dma_tile(QKV, U, j, lds0 + (unsigned)(j - jbase) * 16384u, wid, lane); }
                            else for (int j = U.jlo; j <= U.jhi; ++j) if (!((pim >> (j & 3)) & 1u)) dma_tile(QKV, U, j, lds0 + (unsigned)(j & 3) * 32768u, wid, lane); }
            ATT_WAIT_BAR();
        }
        if (prob == 0 && ui + 1 < 16) { WAVE_ROLE(N, hsn, qon); const bf16_t* Qn = QKV + ((size_t)N.b * SEQ + (size_t)((N.ub + qon + r32) << N.dsh) + N.c) * QKV_LD + N.qcol0 + hsn * 64;
#pragma unroll
            for (int d0 = 0; d0 < 4; ++d0) qn[d0] = *(const bf16x8*)(Qn + d0 * 16 + hi * 8); }
        STAMP(pf, 1);
        unsigned nim = 0u, busy1 = 0u, busy2 = 0u; int nj0 = 0, nj1 = -1;
        if (prob != 0) {
            if (ui + 1 < 16 && N.prob != 0) { if (ncont) { nj0 = 2 * U.uidx + 3; nj1 = 2 * U.uidx + 4 < U.nj - 1 ? 2 * U.uidx + 4 : U.nj - 1; } else { nj0 = N.jlo; nj1 = N.jhi; } }
            for (int j = 2 * U.uidx; j <= U.jhi; ++j) { busy1 |= 1u << (j & 3); if (j >= 2 * U.uidx + 1) busy2 |= 1u << (j & 3); }
        }
        const int jwl = prob == 0 ? U.jlo : 2 * U.uidx - 1 + (wid >> 2), jwh = prob == 0 ? U.jhi : 2 * U.uidx + 1 + (wid >> 2);
        for (int j = U.jlo; j <= U.jhi; ++j) {
            if (prob != 0) {
                const int p = j - (2 * U.uidx - 1);
                if (p == 1) { ATT_WAIT_BAR();
                    if (dry != 2) for (int jn = nj0; jn <= nj1; ++jn) { const unsigned sl = (unsigned)jn & 3u; if (!((busy1 >> sl) & 1u) && !((nim >> sl) & 1u)) { dma_tile(QKV, N, jn, lds0 + sl * 32768u, wid, lane); nim |= 1u << sl; } }
                    if (ui + 1 < 16) { WAVE_ROLE(N, hsn, qon); const bf16_t* Qn = QKV + ((size_t)N.b * SEQ + (size_t)((N.ub + qon + r32) << N.dsh) + N.c) * QKV_LD + N.qcol0 + hsn * 64;
#pragma unroll
                        for (int d0 = 0; d0 < 4; ++d0) qn[d0] = *(const bf16x8*)(Qn + d0 * 16 + hi * 8); } }
                else if (p == 2) { ATT_BAR();
                    if (dry != 2) for (int jn = nj0; jn <= nj1; ++jn) { const unsigned sl = (unsigned)jn & 3u; if (!((busy2 >> sl) & 1u) && !((nim >> sl) & 1u)) { dma_tile(QKV, N, jn, lds0 + sl * 32768u, wid, lane); nim |= 1u << sl; } } }
            }
            STAMP(pf, 4);
            if (dry == 3 || j < jwl || j > jwh) continue;
            const unsigned sbase = prob == 0 ? (unsigned)(j - jbase) * 16384u : (unsigned)(j & 3) * 32768u + (unsigned)hs * 16384u;
            const LAS float* tb = tab + (191 + 64 * j - mqb + 4 * hi - r32);
            const LAS unsigned char* kb = lds + sbase + r32 * 128;
            const int vbb = (int)(lds0 + sbase + 8192) + (4 * hi + ((lane & 15) >> 2)) * 128 + ((lane >> 4) & 1) * 32 + (lane & 3) * 8;
            att_step(fast, o, ol, mrun, qr, tb, kb, vbb, hi, r32, lane, ones);
            STAMP(pf, 3);
        }
        float lrun = ol[0];
        { auto rr = __builtin_amdgcn_permlane32_swap(__float_as_uint(lrun), __float_as_uint(lrun), false, false); lrun = __uint_as_float(rr[0]) + __uint_as_float(rr[1]); }
        if (fast) mrun = 0.f;
        float inv;
        if (prob == 0) { const float sk = P.sink[U.bh0 + hs] * LOG2E - Ch, mn = fmaxf(mrun, sk), a = __builtin_amdgcn_exp2f(mrun - mn); inv = a * __builtin_amdgcn_rcpf(lrun * a + __builtin_amdgcn_exp2f(sk - mn)); }
        else { inv = __builtin_amdgcn_rcpf(lrun); if (hi == 0 && !dry) P.LSE[(size_t)(prob - 1) * MTOK * 8 + grow * 8 + (U.bh0 - 8 * prob) + hs] = Ch + mrun + __log2f(lrun); }
#pragma unroll
        for (int d0 = 0; d0 < 2; ++d0)
#pragma unroll
            for (int gp = 0; gp < 2; ++gp) {
                float v[8];
#pragma unroll
                for (int e = 0; e < 8; ++e) v[e] = o[d0][8 * gp + e] * inv;
                if (prob == 0) {
                    const uint2 ga = gav[4 * d0 + 2 * gp], gb = gav[4 * d0 + 2 * gp + 1]; const unsigned gw[4] = {ga.x, ga.y, gb.x, gb.y};
#pragma unroll
                    for (int e = 0; e < 4; ++e) { const float g0 = bflo(gw[e]), g1 = bfhi(gw[e]); v[2 * e] *= g0 * __builtin_amdgcn_rcpf(1.f + __expf(-g0)); v[2 * e + 1] *= g1 * __builtin_amdgcn_rcpf(1.f + __expf(-g1)); }
                }
                unsigned ax = cvtpk(v[0], v[1]), ay = cvtpk(v[2], v[3]), bx = cvtpk(v[4], v[5]), by = cvtpk(v[6], v[7]);
                { auto r = __builtin_amdgcn_permlane32_swap(ax, bx, false, false); ax = r[0]; bx = r[1]; }
                { auto r = __builtin_amdgcn_permlane32_swap(ay, by, false, false); ay = r[0]; by = r[1]; }
                if (!dry) *(u32x4*)(Qrow + 32 * d0 + 16 * gp + 8 * hi) = (u32x4){ax, ay, bx, by};
            }
        prev_seq = U.seq; prev_u = U.uidx; U = N; pim = nim;
    }
    STAMP(pf, 5);
    ATT_WAIT_BAR();
    STAMP(pf, 6);
#undef WAVE_ROLE
}
#undef ATT_WAIT_BAR
#undef ATT_BAR
}

__device__ __forceinline__ void p3_combine(const Ptrs& P, int vcu, int G, int wave, int lane, int dry) {
    const int h = lane >> 3, NW = G * 8;
    for (int t0 = vcu * 8 + wave; t0 < MTOK; t0 += 4 * NW) {
        float ls[4][3]; u32x4 ov[4][3], gv[4];
#pragma unroll
        for (int u = 0; u < 4; ++u) { const int t = t0 + u * NW; const bool ok = t < MTOK; const size_t tt = ok ? t : t0;
#pragma unroll
            for (int g = 0; g < 3; ++g) { ls[u][g] = P.LSE[(size_t)g * MTOK * 8 + tt * 8 + h]; ov[u][g] = *(const u32x4*)(P.QKV + tt * QKV_LD + C_QB + g * 512 + lane * 8); }
            gv[u] = *(const u32x4*)(P.GAB + tt * 1024 + 512 + lane * 8); }
#pragma unroll
        for (int u = 0; u < 4; ++u) { const int t = t0 + u * NW; if (t >= MTOK) break;
            const float mx = fmaxf(ls[u][0], fmaxf(ls[u][1], ls[u][2]));
            float al[3], sum = 0.f;
#pragma unroll
            for (int g = 0; g < 3; ++g) { al[g] = __builtin_amdgcn_exp2f(ls[u][g] - mx); sum += al[g]; }
            const float inv = __builtin_amdgcn_rcpf(sum);
            float r[8] = {0.f, 0.f, 0.f, 0.f, 0.f, 0.f, 0.f, 0.f};
#pragma unroll
            for (int g = 0; g < 3; ++g) { const unsigned w[4] = {ov[u][g].x, ov[u][g].y, ov[u][g].z, ov[u][g].w}; const float a = al[g] * inv;
#pragma unroll
                for (int e = 0; e < 4; ++e) { r[2 * e] += a * bflo(w[e]); r[2 * e + 1] += a * bfhi(w[e]); } }
            { const unsigned gw[4] = {gv[u].x, gv[u].y, gv[u].z, gv[u].w};
#pragma unroll
              for (int e = 0; e < 4; ++e) { const float g0 = bflo(gw[e]), g1 = bfhi(gw[e]); r[2 * e] *= g0 * __builtin_amdgcn_rcpf(1.f + __expf(-g0)); r[2 * e + 1] *= g1 * __builtin_amdgcn_rcpf(1.f + __expf(-g1)); } }
            u32x4 w; w.x = cvtpk(r[0], r[1]); w.y = cvtpk(r[2], r[3]); w.z = cvtpk(r[4], r[5]); w.w = cvtpk(r[6], r[7]);
            if (!dry) *(u32x4*)(P.QKV + (size_t)t * QKV_LD + 512 + lane * 8) = w;
        }
    }
}

__device__ __forceinline__ void skew_delay(unsigned ticks) {
    if (ticks) { const unsigned long long t0 = __builtin_amdgcn_s_memrealtime(); while (__builtin_amdgcn_s_memrealtime() - t0 < (unsigned long long)ticks) __builtin_amdgcn_s_sleep(8); }
}
#ifndef SKEW1
#define SKEW1 0
#endif
#ifndef USE_CG_SYNC
#define USE_CG_SYNC 0
#endif
#ifndef SKEWN
#define SKEWN 4
#endif
#ifndef SKEW45
#define SKEW45 0
#endif

#define XB_TMO      128
#define XB_XCNT(j)  (256  + 64 * (j))
#define XB_XSUB(j)  (1280 + 64 * (j))
#define XB_XGEN(j)  (2304 + 64 * (j))
#define XB_TOP      3328
#define XB_TOPGEN   3392
#define XCD_BAR_WORDS 3456
#define XB_SPIN_CAP (1u << 18)
__device__ __forceinline__ unsigned xb_ld(unsigned* p)              { return __hip_atomic_load(p, __ATOMIC_RELAXED, __HIP_MEMORY_SCOPE_AGENT); }
__device__ __forceinline__ unsigned xb_add(unsigned* p, unsigned v) { return __hip_atomic_fetch_add(p, v, __ATOMIC_RELAXED, __HIP_MEMORY_SCOPE_AGENT); }
__device__ __forceinline__ unsigned xb_xcc_id() { return (unsigned)__builtin_amdgcn_s_getreg((3 << 11) | 20) & 0xFu; }
#define XB_SPIN(cond, bar) do { unsigned _sp = 0; while (cond) { __builtin_amdgcn_s_sleep(1); \
    if ((++_sp & 255u) == 0u) { if (xb_ld(&(bar)[XB_TMO])) break; if (_sp > XB_SPIN_CAP) { atomicAdd(&(bar)[XB_TMO], 1u); break; } } } } while (0)
struct XcdBarrier { unsigned* bar; unsigned x; volatile LAS unsigned* st; };
__device__ __forceinline__ XcdBarrier xcd_barrier_post(unsigned* bar, volatile LAS unsigned* st) {
    XcdBarrier b; b.bar = bar; b.x = xb_xcc_id(); b.st = st;
    if (threadIdx.x == 0) (void)xb_add(&bar[XB_XCNT(b.x)], 1u);
    return b;
}
__device__ __forceinline__ void xcd_barrier_complete(unsigned* bar, unsigned x, unsigned& nloc, unsigned& nx) {
    const unsigned G = gridDim.x * gridDim.y * gridDim.z;
    unsigned sum, cnt, mine, sp = 0u;
    for (;;) {
        sum = 0u; cnt = 0u; mine = 0u;
#pragma unroll
        for (unsigned j = 0; j < 16; ++j) { const unsigned c = xb_ld(&bar[XB_XCNT(j)]); sum += c; cnt += (c > 0u) ? 1u : 0u; mine = (j == x) ? c : mine; }
        if (sum == G) break;
        __builtin_amdgcn_s_sleep(1);
        if ((++sp & 255u) == 0u) { if (xb_ld(&bar[XB_TMO])) break; if (sp > XB_SPIN_CAP) { atomicAdd(&bar[XB_TMO], 1u); break; } }
    }
    nloc = mine > 0u ? mine : 1u; nx = cnt > 0u ? cnt : 1u;
}
__device__ __forceinline__ void xcd_barrier(const XcdBarrier& b) {
    asm volatile("s_waitcnt vmcnt(0)" ::: "memory");
    __syncthreads();
    if (threadIdx.x == 0) {
        unsigned* bar = b.bar;
        __builtin_amdgcn_s_waitcnt(0);
        unsigned nloc = b.st[0], nx = b.st[1];
        if (nloc == 0u) { xcd_barrier_complete(bar, b.x, nloc, nx); b.st[0] = nloc; b.st[1] = nx; }
        const unsigned old = xb_add(&bar[XB_XSUB(b.x)], 1u);
        const unsigned gen = old / nloc;
        if (old + 1u == (gen + 1u) * nloc) {
            __builtin_amdgcn_fence(__ATOMIC_RELEASE, "agent");
            asm volatile("s_waitcnt vmcnt(0)" ::: "memory");
            const unsigned og = xb_add(&bar[XB_TOP], 1u);
            const unsigned tg = og / nx;
            if (og + 1u == (tg + 1u) * nx) xb_add(&bar[XB_TOPGEN], 1u);
            else XB_SPIN(xb_ld(&bar[XB_TOPGEN]) == tg, bar);
            __builtin_amdgcn_fence(__ATOMIC_ACQUIRE, "agent");
            xb_add(&bar[XB_XGEN(b.x)], 1u);
            asm volatile("s_waitcnt vmcnt(0)" ::: "memory");
        } else {
            XB_SPIN(xb_ld(&bar[XB_XGEN(b.x)]) == gen, bar);
            __builtin_amdgcn_fence(__ATOMIC_ACQUIRE, "agent");
            asm volatile("s_waitcnt vmcnt(0)" ::: "memory");
        }
    }
    __syncthreads();
}
struct Args { const float* in[13]; float* out; unsigned char* ws; int ph_lo, ph_hi, dry, pad; };
__global__ void __launch_bounds__(512, 2) mega_fwd(Args a) {
    extern __shared__ __attribute__((aligned(16))) unsigned char lds_raw[];
    LAS unsigned char* lds = (LAS unsigned char*)lds_raw;
    cg::grid_group grid = cg::this_grid();
    const int tid = threadIdx.x, lane = tid & 63, wave = __builtin_amdgcn_readfirstlane(tid >> 6);
    const int G = gridDim.x, bx = blockIdx.x, vcu = (G % 8 == 0) ? (bx % 8) * (G / 8) + bx / 8 : bx;
    Ptrs P;
    P.x = a.in[0]; P.gain = a.in[1]; P.Win = a.in[2]; P.qna = a.in[3]; P.kna = a.in[4]; P.qnb = a.in[5]; P.knb = a.in[6]; P.sink = a.in[7]; P.relb = a.in[8];
    P.Wa = a.in[9]; P.Wb = a.in[10]; P.bm = a.in[11]; P.Wout = a.in[12]; P.out = a.out;
    unsigned char* ws = a.ws;
    P.WinT = (bf16_t*)(ws + WS_WIN); P.WabT = (bf16_t*)(ws + WS_WAB); P.WoutT = (bf16_t*)(ws + WS_WOUT); P.XN = (bf16_t*)(ws + WS_XN); P.MER = P.XN;
    P.GAB = (bf16_t*)(ws + WS_GAB); P.QKV = (bf16_t*)(ws + WS_QKV); P.LSE = (float*)(ws + WS_LSE); P.TABG = (float*)(ws + WS_CTL + 65536); P.CH = (float*)(ws + WS_CTL + 65536 + 32 * 384 * 4); P.Rb = (bf16_t*)a.out; P.G1b = P.Rb + (size_t)MTOK * 1024;
    const int lo = a.ph_lo, hi = a.ph_hi;
    { volatile LAS unsigned* stw = (volatile LAS unsigned*)(lds + WSF_OFF + 2048); if (tid < 2) stw[tid] = 0u; }
    __syncthreads();
    const XcdBarrier xbar = xcd_barrier_post((unsigned*)(a.ws + WS_CTL), (volatile LAS unsigned*)(lds + WSF_OFF + 2048));
    if (hi > 1000) grid.sync();
#if USE_CG_SYNC
#define GRID_BAR() grid.sync()
#else
#define GRID_BAR() xcd_barrier(xbar)
#endif
    Prof pf; pf.tl = 0; pf.tp = 0;
#pragma unroll
    for (int k = 0; k < 32; ++k) pf.acc[k] = 0;
#if PROBE
    pf.tl = __builtin_amdgcn_s_memrealtime(); pf.tp = pf.tl;
#endif
#ifndef PH_EN
#define PH_EN 0x3f
#endif
#define IN(k) (((PH_EN >> (k)) & 1) && lo <= (k) && (k) < hi)
#define BOTH(k) (IN(k) && IN((k) + 1))
#ifndef PH_REPEAT
#define PH_REPEAT 0
#endif
#ifndef DRY_MODE
#define DRY_MODE 1
#endif
#define NREP(k) (((PH_REPEAT >> (k)) & 1) ? 2 : 1)
    if (IN(0)) { p0_prologue(lds, P, vcu, G, wave, lane); PSTAMP(pf, 8); if (BOTH(0)) GRID_BAR(); SSTAMP(pf, 24); }
    if (IN(1)) {
        skew_delay((unsigned)(SKEW1) * (unsigned)((bx >> 3) & (SKEWN - 1)));
        pg8::Gemm g{P.XN, P.WinT, MTOK, NIN, 1024, 1024}; pg8::StaticOrder S; S.init(MTOK, NIN, G, bx);
        EpiP1 E{P.QKV, P.GAB, P.Rb, P.G1b, P.qna, P.kna, P.qnb, P.knb, P.bm};
        pg8::gemm_phase<EpiP1, true, 16>(lds, g, S, E, pf);
        PSTAMP(pf, 9);
        if (BOTH(1)) GRID_BAR();
        SSTAMP(pf, 25);
    }
    if (IN(2)) { att::attn_phase(lds, P, vcu, a.dry, pf); PSTAMP(pf, 10); if (BOTH(2)) GRID_BAR(); SSTAMP(pf, 26); }
    if (IN(3)) { p3_combine(P, vcu, G, wave, lane, a.dry); PSTAMP(pf, 11); if (BOTH(3)) GRID_BAR(); SSTAMP(pf, 27); }
    if (IN(4)) {
        skew_delay((unsigned)(SKEW45) * (unsigned)((bx >> 3) & 1));
        pg8::Gemm g{P.QKV, P.WabT, MTOK, 1024, 1024, QKV_LD}; pg8::StaticOrder S; S.init(MTOK, 1024, G, bx);
        EpiP4 E{P.Rb, P.G1b, P.MER};
        pg8::gemm_phase<EpiP4, true, 20>(lds, g, S, E, pf);
        PSTAMP(pf, 12);
        if (BOTH(4)) GRID_BAR();
        SSTAMP(pf, 28);
    }
    if (IN(5)) {
        skew_delay((unsigned)(SKEW45) * (unsigned)((bx >> 3) & 1));
        pg8::Gemm g{P.MER, P.WoutT, MTOK, 1024, 1024, 1024}; pg8::StaticOrder S; S.init(MTOK, 1024, G, bx);
        EpiP5 E{P.x, P.out};
        pg8::gemm_phase<EpiP5, true, 20>(lds, g, S, E, pf);
        PSTAMP(pf, 13);
    }
#if PROBE
    { unsigned tot = 0;
#pragma unroll
      for (int k = 0; k < 32; ++k) if ((PROBE_MASK >> k) & 1u) tot += pf.acc[k];
      if (PROBE_BX < 0 || bx == PROBE_BX) skew_delay(tot); }
#endif
#undef IN
#undef BOTH
}


#ifndef MEGA_MASK
#define MEGA_MASK 0x3f
#endif
#ifndef ONE_LAUNCH
#define ONE_LAUNCH 1
#endif
extern "C" void kernel_launch(void* const* d_in, const int* in_sizes, int n_in, void* d_out, int out_size, void* d_ws, size_t ws_size, hipStream_t stream) {
    static int grid = 0;
    if (grid == 0) {
        if (n_in != 13 || out_size != MTOK * DM || ws_size < WS_END) { fprintf(stderr, "kernel_launch: unexpected shapes (n_in %d out %d ws %zu)\n", n_in, out_size, ws_size); grid = -1; return; }
        int dev = 0, cus = 0, per_cu = 0;
        if (hipGetDevice(&dev) != hipSuccess || hipDeviceGetAttribute(&cus, hipDeviceAttributeMultiprocessorCount, dev) != hipSuccess) { grid = -1; return; }
        if (hipFuncSetAttribute((const void*)mega_fwd, hipFuncAttributeMaxDynamicSharedMemorySize, LDS_BYTES) != hipSuccess) { fprintf(stderr, "kernel_launch: hipFuncSetAttribute failed\n"); grid = -1; return; }
        if (hipOccupancyMaxActiveBlocksPerMultiprocessor(&per_cu, (const void*)mega_fwd, 512, LDS_BYTES) != hipSuccess || per_cu < 1) { fprintf(stderr, "kernel_launch: occupancy query says %d blocks per CU\n", per_cu); (void)hipGetLastError(); grid = -1; return; }
        grid = cus;
    }
    if (grid < 0) return;
    Args a{};
    for (int i = 0; i < 13; ++i) a.in[i] = (const float*)d_in[i];
    a.out = (float*)d_out; a.ws = (unsigned char*)d_ws;
#if ONE_LAUNCH
    a.ph_lo = 0; a.ph_hi = 6;
    if (hipMemsetAsync((char*)d_ws + WS_CTL, 0, 16384, stream) != hipSuccess) { fprintf(stderr, "kernel_launch: memset of the barrier words failed\n"); return; }
    void* args[] = {&a};
    hipError_t e = hipLaunchCooperativeKernel((const void*)mega_fwd, dim3(grid), dim3(512), args, LDS_BYTES, stream);
    if (e != hipSuccess) fprintf(stderr, "cooperative launch failed: %s (grid %d)\n", hipGetErrorString(e), grid);
#else
    const float* x = a.in[0]; unsigned char* ws = a.ws;
    bf16_t* XN = (bf16_t*)(ws + WS_XN); bf16_t* MER = XN; bf16_t* GAB = (bf16_t*)(ws + WS_GAB); bf16_t* QKV = (bf16_t*)(ws + WS_QKV); float* LSE = (float*)(ws + WS_LSE);
    bf16_t* Rb = (bf16_t*)d_out; bf16_t* G1b = Rb + (size_t)MTOK * 1024;
    for (int ph = 0; ph < 6; ++ph) {
        if ((MEGA_MASK >> ph) & 1) { a.ph_lo = ph; a.ph_hi = ph + 1; for (int rep = 0; rep < NREP(ph); ++rep) { a.dry = (rep + 1 < NREP(ph)) ? DRY_MODE : 0; hipLaunchKernelGGL(mega_fwd, dim3(grid), dim3(512), LDS_BYTES, stream, a); } continue; }
        switch (ph) {
        case 0: p0_naive<<<MTOK / 4, 256, 0, stream>>>(x, a.in[1], XN); break;
        case 1: p1_naive<<<dim3(116, MTOK / 64), 256, 0, stream>>>(XN, a.in[2], a.in[3], a.in[4], a.in[5], a.in[6], a.in[11], QKV, GAB, Rb, G1b); break;
        case 2: attn_naive<0><<<dim3(MTOK / 256, 8), 256, 0, stream>>>(QKV, GAB, a.in[8], a.in[7], LSE); attn_naive<1><<<dim3(MTOK / 256, 8), 256, 0, stream>>>(QKV, GAB, a.in[8], a.in[7], LSE);
                attn_naive<2><<<dim3(MTOK / 256, 8), 256, 0, stream>>>(QKV, GAB, a.in[8], a.in[7], LSE); attn_naive<3><<<dim3(MTOK / 256, 8), 256, 0, stream>>>(QKV, GAB, a.in[8], a.in[7], LSE); break;
        case 3: p2c_combine<<<MTOK / 4, 256, 0, stream>>>(QKV, GAB, LSE); break;
        case 4: p3_naive<<<dim3(16, MTOK / 64), 256, 0, stream>>>(QKV, a.in[9], a.in[10], Rb, G1b, MER); break;
        case 5: p4_naive<<<dim3(16, MTOK / 64), 256, 0, stream>>>(MER, a.in[12], x, (float*)d_out); break;
        }
    }
#endif
}
```
